# Optimizing an MI355X kernel written in HIP

```python
import math
import jax, jax.numpy as jnp
from jax import lax
import numpy as np

D_MODEL = 1024
BATCH = 4
SEQ = 8192
DEPTH = 2
DEC_BATCH = 8
DEC_SEQ = 64
PAST_LEN = 2048

CHUNK = 64
Q_BLOCK = 128
SB_HEADS = 8
SB_HEAD_DIM = D_MODEL // 16
SB_WIDTH = SB_HEADS * SB_HEAD_DIM
GDN_HEADS = 4
GDN_HEAD_DIM = D_MODEL // 8
GDN_WIDTH = GDN_HEADS * GDN_HEAD_DIM
CONV_WIDTH = 4
CONV_DIM = 3 * GDN_WIDTH
N_BRANCH = 2
D_FF = 11 * D_MODEL // 4
NORM_EPS = 1e-6
IN_SIZES = (SB_WIDTH, SB_WIDTH, SB_WIDTH, CONV_DIM, GDN_WIDTH, GDN_HEADS, GDN_HEADS, N_BRANCH * D_MODEL)
IN_DIM = sum(IN_SIZES)

kernel_name = 'stickbreak_gdn_macaron_stream_step'


def rms_norm(x, gain):
    xf = x.astype(jnp.float32)
    y = xf * lax.rsqrt(jnp.mean(xf * xf, axis=-1, keepdims=True) + NORM_EPS)
    return (y * gain.astype(jnp.float32)).astype(x.dtype)


def l2_norm(x):
    xf = x.astype(jnp.float32)
    return xf * lax.rsqrt(jnp.sum(xf * xf, axis=-1, keepdims=True) + NORM_EPS)


def swiglu_ffn(h, w_up, w_down):
    gate, up = jnp.split(h @ w_up, 2, axis=-1)
    return (jax.nn.silu(gate) * up) @ w_down


def causal_conv(u, hist, w):
    L = u.shape[1]
    up = jnp.concatenate([hist.astype(u.dtype), u], axis=1)
    y = up[:, 0:L] * w[0]
    for i in range(1, CONV_WIDTH):
        y = y + up[:, i:i + L] * w[i]
    return y, up[:, L:]


def stick_breaking_block(q, k, v, q_pos, k_pos):
    z = jnp.einsum('bqhd,bkhd->bhqk', q, k, preferred_element_type=jnp.float32) * (SB_HEAD_DIM ** -0.5)
    visible = k_pos[None, :] < q_pos[:, None]
    neg_log_keep = jnp.where(visible, jax.nn.softplus(z), 0.0)
    between = lax.cumsum(neg_log_keep, axis=3, reverse=True) - neg_log_keep
    log_a = jax.nn.log_sigmoid(z) - between
    a = jnp.where(visible, jnp.exp(log_a), 0.0)
    return jnp.einsum('bhqk,bkhd->bqhd', a.astype(v.dtype), v)


def stick_breaking_prompt(q, k, v):
    B, L, H, D = q.shape
    nb = L // Q_BLOCK
    qb = q.reshape(B, nb, Q_BLOCK, H, D).swapaxes(0, 1)
    k_pos = jnp.arange(L, dtype=jnp.int32)

    def one_block(args):
        q_blk, blk = args
        q_pos = blk * Q_BLOCK + jnp.arange(Q_BLOCK, dtype=jnp.int32)
        return stick_breaking_block(q_blk, k, v, q_pos, k_pos)

    o = lax.map(one_block, (qb, jnp.arange(nb, dtype=jnp.int32)))
    return o.swapaxes(0, 1).reshape(B, L, H, D)


def gated_delta_rule(q, k, v, g, beta, s0, chunk):
    B, L, H, _ = q.shape
    DV = v.shape[-1]
    n = L // chunk
    f32 = jnp.float32

    def blocks(t):
        t = t.astype(f32).reshape((B, n, chunk, H) + t.shape[3:])
        return jnp.moveaxis(t, (1, 3), (0, 2))

    qc, kc, vc, gc, bc = blocks(q), blocks(k), blocks(v), blocks(g), blocks(beta)
    gcum = jnp.cumsum(gc, axis=-1)
    idx = jnp.arange(chunk)
    incl = idx[:, None] >= idx[None, :]
    strict = idx[:, None] > idx[None, :]
    gamma = jnp.exp(jnp.where(incl, gcum[..., :, None] - gcum[..., None, :], -jnp.inf))
    kb = kc * bc[..., None]
    a_strict = jnp.where(strict, jnp.einsum('nbhid,nbhjd->nbhij', kb, kc) * gamma, 0.0)
    t_mat = a_strict + jnp.eye(chunk, dtype=f32)
    rhs = jnp.concatenate([vc * bc[..., None], kb * jnp.exp(gcum)[..., None]], axis=-1)
    sol = lax.linalg.triangular_solve(t_mat, rhs, left_side=True, lower=True, unit_diagonal=True)
    u, w = sol[..., :DV], sol[..., DV:]
    qk = jnp.einsum('nbhid,nbhjd->nbhij', qc, kc) * gamma
    q_dec = qc * jnp.exp(gcum)[..., None]
    k_end = kc * jnp.exp(gcum[..., -1:] - gcum)[..., None]
    chunk_decay = jnp.exp(gcum[..., -1])

    def step(s, xs):
        u_c, w_c, qk_c, qd_c, ke_c, cd_c = xs
        v_new = u_c - jnp.einsum('bhck,bhkv->bhcv', w_c, s)
        o = jnp.einsum('bhck,bhkv->bhcv', qd_c, s) + jnp.einsum('bhij,bhjv->bhiv', qk_c, v_new)
        s = s * cd_c[..., None, None] + jnp.einsum('bhck,bhcv->bhkv', ke_c, v_new)
        return s, o

    s_fin, o = lax.scan(step, s0.astype(f32), (u, w, qk, q_dec, k_end, chunk_decay))
    o = jnp.moveaxis(o, (0, 2), (1, 3)).reshape(B, L, H, DV)
    return o, s_fin


def gdn_branch(qkv_raw, z, b, a, conv_hist, s0, conv_w, a_log, dt_bias, head_gain, chunk):
    B, L, _ = qkv_raw.shape
    qkv, conv_new = causal_conv(qkv_raw, conv_hist, conv_w)
    qkv = jax.nn.silu(qkv)
    q, k, v = jnp.split(qkv, 3, axis=-1)
    hs = (B, L, GDN_HEADS, GDN_HEAD_DIM)
    q = l2_norm(q.reshape(hs)) * (GDN_HEAD_DIM ** -0.5)
    k = l2_norm(k.reshape(hs))
    v = v.reshape(hs)
    beta = jax.nn.sigmoid(b.astype(jnp.float32))
    g = -jnp.exp(a_log.astype(jnp.float32)) * jax.nn.softplus(a.astype(jnp.float32) + dt_bias.astype(jnp.float32))
    o, s_fin = gated_delta_rule(q, k, v, g, beta, s0, chunk)
    o = rms_norm(o, head_gain) * jax.nn.silu(z.reshape(hs).astype(jnp.float32))
    return o.reshape(B, L, GDN_WIDTH).astype(qkv_raw.dtype), s_fin, conv_new


def token_mixer(h, w_in, conv_w, a_log, dt_bias, gdn_gain, w_branch_sb, w_branch_gdn, w_out,
                past_k, past_v, conv_hist, s0, chunk):
    B, L, _ = h.shape
    split_points = np.cumsum(IN_SIZES)[:-1].tolist()
    sb_q, sb_k, sb_v, gdn_qkv, gdn_z, gdn_b, gdn_a, gate_logits = jnp.split(h @ w_in, split_points, axis=-1)
    hs = (B, L, SB_HEADS, SB_HEAD_DIM)
    sb_q, sb_k, sb_v = sb_q.reshape(hs), sb_k.reshape(hs), sb_v.reshape(hs)
    if past_k is None:
        o_sb = stick_breaking_prompt(sb_q, sb_k, sb_v)
    else:
        P = past_k.shape[1]
        k_all = jnp.concatenate([past_k.astype(sb_k.dtype), sb_k], axis=1)
        v_all = jnp.concatenate([past_v.astype(sb_v.dtype), sb_v], axis=1)
        q_pos = P + jnp.arange(L, dtype=jnp.int32)
        k_pos = jnp.arange(P + L, dtype=jnp.int32)
        o_sb = stick_breaking_block(sb_q, k_all, v_all, q_pos, k_pos)
    o_gdn, s_fin, conv_new = gdn_branch(gdn_qkv, gdn_z, gdn_b, gdn_a, conv_hist, s0, conv_w,
                                        a_log, dt_bias, gdn_gain, chunk)
    gates = jax.nn.sigmoid(gate_logits.astype(jnp.float32)).reshape(B, L, N_BRANCH, D_MODEL)
    merged = (gates[:, :, 0] * (o_sb.reshape(B, L, SB_WIDTH) @ w_branch_sb)
              + gates[:, :, 1] * (o_gdn @ w_branch_gdn))
    return merged.astype(h.dtype) @ w_out, sb_k, sb_v, s_fin, conv_new


def encoder_layer(x, norm_g, w1_up, w1_down, w_in, conv_w, a_log, dt_bias, gdn_gain,
                  w_branch_sb, w_branch_gdn, w_out, w2_up, w2_down,
                  past_k, past_v, conv_hist, s0, chunk):
    x = x + 0.5 * rms_norm(swiglu_ffn(rms_norm(x, norm_g[0]), w1_up, w1_down), norm_g[1])
    m, k_rows, v_rows, s_fin, conv_new = token_mixer(
        rms_norm(x, norm_g[2]), w_in, conv_w, a_log, dt_bias, gdn_gain, w_branch_sb, w_branch_gdn,
        w_out, past_k, past_v, conv_hist, s0, chunk)
    x = x + rms_norm(m, norm_g[3])
    x = x + 0.5 * rms_norm(swiglu_ffn(rms_norm(x, norm_g[4]), w2_up, w2_down), norm_g[5])
    return x, k_rows, v_rows, s_fin, conv_new


def setup_inputs(seed: int = 0) -> dict:
    key = jax.random.key(seed)
    ks = jax.random.split(key, 20)
    f32 = jnp.float32

    def nrm(k, shape, scale):
        return jax.random.normal(k, shape, f32) * scale

    dt = jnp.exp(jax.random.uniform(ks[13], (DEPTH, GDN_HEADS), f32, math.log(1e-3), math.log(1e-1)))
    return {
        'x_prompt': nrm(ks[0], (BATCH, SEQ, D_MODEL), 1.0),
        'x_sample': nrm(ks[1], (DEC_BATCH, DEC_SEQ, D_MODEL), 1.0),
        'cache_sb_k': nrm(ks[2], (DEPTH, DEC_BATCH, PAST_LEN, SB_HEADS, SB_HEAD_DIM), 1.0),
        'cache_sb_v': nrm(ks[3], (DEPTH, DEC_BATCH, PAST_LEN, SB_HEADS, SB_HEAD_DIM), 1.0),
        'state_gdn': nrm(ks[4], (DEPTH, DEC_BATCH, GDN_HEADS, GDN_HEAD_DIM, GDN_HEAD_DIM), 0.1),
        'state_conv': nrm(ks[5], (DEPTH, DEC_BATCH, CONV_WIDTH - 1, CONV_DIM), 1.0),
        'norm_gains': 1.0 + nrm(ks[6], (DEPTH, 6, D_MODEL), 0.02),
        'w_ffn1_up': nrm(ks[7], (DEPTH, D_MODEL, 2 * D_FF), D_MODEL ** -0.5),
        'w_ffn1_down': nrm(ks[8], (DEPTH, D_FF, D_MODEL), D_FF ** -0.5),
        'w_in': nrm(ks[9], (DEPTH, D_MODEL, IN_DIM), D_MODEL ** -0.5),
        'conv_w': nrm(ks[10], (DEPTH, CONV_WIDTH, CONV_DIM), CONV_WIDTH ** -0.5),
        'gdn_a_log': jnp.log(jax.random.uniform(ks[11], (DEPTH, GDN_HEADS), f32, 1.0, 16.0)),
        'gdn_dt_bias': dt + jnp.log(-jnp.expm1(-dt)),
        'gdn_norm_gain': 1.0 + nrm(ks[12], (DEPTH, GDN_HEAD_DIM), 0.02),
        'w_branch_sb': nrm(ks[14], (DEPTH, SB_WIDTH, D_MODEL), SB_WIDTH ** -0.5),
        'w_branch_gdn': nrm(ks[15], (DEPTH, GDN_WIDTH, D_MODEL), GDN_WIDTH ** -0.5),
        'w_out': nrm(ks[16], (DEPTH, D_MODEL, D_MODEL), D_MODEL ** -0.5),
        'w_ffn2_up': nrm(ks[17], (DEPTH, D_MODEL, 2 * D_FF), D_MODEL ** -0.5),
        'w_ffn2_down': nrm(ks[18], (DEPTH, D_FF, D_MODEL), D_FF ** -0.5),
    }


def reference(x_prompt, x_sample, cache_sb_k, cache_sb_v, state_gdn, state_conv, norm_gains,
              w_ffn1_up, w_ffn1_down, w_in, conv_w, gdn_a_log, gdn_dt_bias, gdn_norm_gain,
              w_branch_sb, w_branch_gdn, w_out, w_ffn2_up, w_ffn2_down):
    def run(x, past_k, past_v, conv_hist, s0, chunk):
        k_list, v_list, s_list, c_list = [], [], [], []
        for l in range(DEPTH):
            pk = None if past_k is None else past_k[l]
            pv = None if past_v is None else past_v[l]
            x, k_rows, v_rows, s_fin, conv_new = encoder_layer(
                x, norm_gains[l], w_ffn1_up[l], w_ffn1_down[l], w_in[l], conv_w[l], gdn_a_log[l],
                gdn_dt_bias[l], gdn_norm_gain[l], w_branch_sb[l], w_branch_gdn[l], w_out[l],
                w_ffn2_up[l], w_ffn2_down[l], pk, pv, conv_hist[l], s0[l], chunk)
            k_list.append(k_rows)
            v_list.append(v_rows)
            s_list.append(s_fin)
            c_list.append(conv_new)
        return (x, jnp.stack(k_list).astype(cache_sb_k.dtype), jnp.stack(v_list).astype(cache_sb_v.dtype),
                jnp.stack(s_list).astype(state_gdn.dtype), jnp.stack(c_list).astype(state_conv.dtype))

    zero_conv = jnp.zeros((DEPTH, x_prompt.shape[0], CONV_WIDTH - 1, CONV_DIM), state_conv.dtype)
    zero_state = jnp.zeros((DEPTH, x_prompt.shape[0], GDN_HEADS, GDN_HEAD_DIM, GDN_HEAD_DIM), state_gdn.dtype)
    y_prompt, pk, pv, ps, pc = run(x_prompt, None, None, zero_conv, zero_state, CHUNK)
    y_sample, sk, sv, ss, sc = run(x_sample, cache_sb_k, cache_sb_v, state_conv, state_gdn, x_sample.shape[1])
    return (y_prompt, y_sample, pk, pv, ps, pc, sk, sv, ss, sc)
```

```cpp
#include <hip/hip_runtime.h>
#include <hip/hip_cooperative_groups.h>
#include <cstdio>
#include <cstdint>
namespace cg = cooperative_groups;
namespace pg8 {
#define PG8_LAS __attribute__((address_space(3)))
typedef unsigned short bf16_t;
typedef short bf16x8 __attribute__((ext_vector_type(8)));
typedef float f32x4 __attribute__((ext_vector_type(4)));
typedef unsigned u32x4 __attribute__((ext_vector_type(4)));
constexpr int BM = 256, BK = 64, HALF = 128, HTB = HALF * BK * 2  , STAGE_BYTES = 8 * HTB, NXCD = 8, WGM = 8;

__host__ __device__ __forceinline__ int lds_byte(int r, int c) { const int st = (r >> 4) * 2 + (c >> 5), rr = r & 15, cc = c & 31, ob = rr * 64 + cc * 2; return st * 1024 + (ob ^ (((ob >> 9) & 1) << 5)); }
__host__ __device__ __forceinline__ void stage_rc(int b, int& R, int& C) { const int st = b / 1024, sb = b % 1024, swz = sb ^ (((sb >> 9) & 1) << 5); R = (st >> 1) * 16 + swz / 64; C = (st & 1) * 32 + (swz % 64) / 2; }
__host__ __device__ __forceinline__ int perm32(int rho) { const int n = rho >> 4, i = rho & 15; return 8 * (i >> 2) + 4 * n + (i & 3); }

struct Unit { int pm, pn; };
struct Gemm { const bf16_t* A; const bf16_t* Bt; int M, N, K, lda; };

struct StaticOrder {
    int nM, nN, nwg, G, c;
    __host__ __device__ void init(int M, int N, int G_, int c_) { nM = M / BM; nN = N / BM; nwg = nM * nN; G = G_; c = c_; }
    __host__ __device__ bool next(int i, Unit& u) const {
        const long L = (long)i * G + c; if (L >= nwg) return false;
        int wgid = (int)L; { const int q = nwg / NXCD, r = nwg % NXCD, xcd = wgid % NXCD, off = wgid / NXCD; wgid = (xcd < r ? xcd * (q + 1) : r * (q + 1) + (xcd - r) * q) + off; }
        const int nig = WGM * nN, gid = wgid / nig, fm = gid * WGM, gsz = (nM - fm) < WGM ? (nM - fm) : WGM;
        u.pm = fm + ((wgid % nig) % gsz); u.pn = (wgid % nig) / gsz; return true;
    }
    __device__ __forceinline__ void a_ready(const Unit&) const {}
    __device__ __forceinline__ void done(const Unit&) const {}
};


__device__ __forceinline__ unsigned cvt_pk_bf16(float lo, float hi) { typedef float f2_ __attribute__((ext_vector_type(2))); typedef __bf16 b2_ __attribute__((ext_vector_type(2))); f2_ v = {lo, hi}; b2_ b = __builtin_convertvector(v, b2_); return __builtin_bit_cast(unsigned, b); }
__device__ __forceinline__ float bflo(unsigned u) { return __uint_as_float(u << 16); }
__device__ __forceinline__ float bfhi(unsigned u) { return __uint_as_float(u & 0xffff0000u); }
__device__ __forceinline__ float sigm(float x) { return __builtin_amdgcn_rcpf(1.f + __builtin_amdgcn_exp2f(-1.4426950408889634f * x)); }
__device__ __forceinline__ u32x4 pack8(const f32x4& a, const f32x4& b) { u32x4 w; w.x = cvt_pk_bf16(a[0], a[1]); w.y = cvt_pk_bf16(a[2], a[3]); w.z = cvt_pk_bf16(b[0], b[1]); w.w = cvt_pk_bf16(b[2], b[3]); return w; }

struct EpiPlain {
    static constexpr bool PERM = true, AFTER_DRAIN = false; bf16_t* O; int ldc;
    __device__ __forceinline__ void operator()(const f32x4 (&acc)[2][2][4][2], const Unit& u, int wr, int wc, int fr, int fq) const {
        const int row0 = u.pm * BM + wr * 64 + fr, col0 = u.pn * BM + wc * 32 + 8 * fq;
#pragma unroll
        for (int ai = 0; ai < 2; ++ai)
#pragma unroll
            for (int m = 0; m < 4; ++m) { bf16_t* rowp = O + (size_t)(row0 + ai * HALF + m * 16) * ldc + col0;
#pragma unroll
                for (int bj = 0; bj < 2; ++bj) *(u32x4*)(rowp + bj * HALF) = pack8(acc[ai][bj][m][0], acc[ai][bj][m][1]); }
    }
};
struct EpiSwiglu {
    static constexpr bool PERM = true, AFTER_DRAIN = false; bf16_t* O; int ldc;
    __device__ __forceinline__ void operator()(const f32x4 (&acc)[2][2][4][2], const Unit& u, int wr, int wc, int fr, int fq) const {
        const int row0 = u.pm * BM + wr * 64 + fr, col0 = u.pn * HALF + wc * 32 + 8 * fq;
#pragma unroll
        for (int ai = 0; ai < 2; ++ai)
#pragma unroll
            for (int m = 0; m < 4; ++m) { bf16_t* rowp = O + (size_t)(row0 + ai * HALF + m * 16) * ldc + col0; f32x4 r0, r1;
#pragma unroll
                for (int e = 0; e < 4; ++e) { const float g0 = acc[ai][0][m][0][e], g1 = acc[ai][0][m][1][e]; r0[e] = g0 * sigm(g0) * acc[ai][1][m][0][e]; r1[e] = g1 * sigm(g1) * acc[ai][1][m][1][e]; }
                *(u32x4*)rowp = pack8(r0, r1); }
    }
};
struct EpiYss {
    static constexpr bool PERM = true, AFTER_DRAIN = false; bf16_t* O; float* rowss;
    __device__ __forceinline__ void operator()(const f32x4 (&acc)[2][2][4][2], const Unit& u, int wr, int wc, int fr, int fq) const {
        const int row0 = u.pm * BM + wr * 64 + fr, col0 = u.pn * BM + wc * 32 + 8 * fq;
#pragma unroll
        for (int ai = 0; ai < 2; ++ai)
#pragma unroll
            for (int m = 0; m < 4; ++m) { const int row = row0 + ai * HALF + m * 16; bf16_t* rowp = O + (size_t)row * 1024 + col0; float ss = 0.f;
#pragma unroll
                for (int bj = 0; bj < 2; ++bj) { const f32x4 a = acc[ai][bj][m][0], b = acc[ai][bj][m][1];
                    ss += (a[0] * a[0] + a[1] * a[1]) + (a[2] * a[2] + a[3] * a[3]) + (b[0] * b[0] + b[1] * b[1]) + (b[2] * b[2] + b[3] * b[3]);
                    *(u32x4*)(rowp + bj * HALF) = pack8(a, b); }
                ss += __shfl_xor(ss, 16); ss += __shfl_xor(ss, 32);
                if (fq == 0) rowss[(size_t)row * 16 + u.pn * 4 + wc] = ss; }
    }
};
struct EpiIn {
    static constexpr bool PERM = true, AFTER_DRAIN = false; bf16_t* P; int pitch; float* kp; float* vp; float* ks; float* vs; int mp;
    __device__ __forceinline__ void operator()(const f32x4 (&acc)[2][2][4][2], const Unit& u, int wr, int wc, int fr, int fq) const {
        const int row0 = u.pm * BM + wr * 64 + fr, col0 = u.pn * BM + wc * 32 + 8 * fq;
        const bool kv = (u.pn >= 2 && u.pn < 6); const bool isk = u.pn < 4;
#pragma unroll
        for (int ai = 0; ai < 2; ++ai)
#pragma unroll
            for (int m = 0; m < 4; ++m) { const int row = row0 + ai * HALF + m * 16; bf16_t* rowp = P + (size_t)row * pitch + col0;
#pragma unroll
                for (int bj = 0; bj < 2; ++bj) { if (col0 + bj * HALF < pitch) *(u32x4*)(rowp + bj * HALF) = pack8(acc[ai][bj][m][0], acc[ai][bj][m][1]);
                    if (kv) { const int cc = col0 + bj * HALF - (isk ? 512 : 1024);
                        float* o = (row < mp) ? ((isk ? kp : vp) + (size_t)row * 512 + cc) : ((isk ? ks : vs) + (size_t)(row - mp) * 512 + cc);
                        *(f32x4*)o = acc[ai][bj][m][0]; *(f32x4*)(o + 4) = acc[ai][bj][m][1]; } } }
    }
};
struct EpiGate {
    static constexpr bool PERM = true, AFTER_DRAIN = false; bf16_t* T0; const bf16_t* T1;
    __device__ __forceinline__ void operator()(const f32x4 (&acc)[2][2][4][2], const Unit& u, int wr, int wc, int fr, int fq) const {
        const int row0 = u.pm * BM + wr * 64 + fr, col0 = u.pn * HALF + wc * 32 + 8 * fq;
#pragma unroll
        for (int ai = 0; ai < 2; ++ai)
#pragma unroll
            for (int m = 0; m < 4; ++m) { const size_t off = (size_t)(row0 + ai * HALF + m * 16) * 1024 + col0;
                const u32x4 a = *(const u32x4*)(T0 + off), b = *(const u32x4*)(T1 + off); f32x4 r0, r1;
#pragma unroll
                for (int e = 0; e < 4; ++e) { const unsigned wa0 = a[e >> 1], wb0 = b[e >> 1], wa1 = a[2 + (e >> 1)], wb1 = b[2 + (e >> 1)];
                    const float t00 = (e & 1) ? bfhi(wa0) : bflo(wa0), t10 = (e & 1) ? bfhi(wb0) : bflo(wb0), t01 = (e & 1) ? bfhi(wa1) : bflo(wa1), t11 = (e & 1) ? bfhi(wb1) : bflo(wb1);
                    r0[e] = sigm(acc[ai][0][m][0][e]) * t00 + sigm(acc[ai][1][m][0][e]) * t10;
                    r1[e] = sigm(acc[ai][0][m][1][e]) * t01 + sigm(acc[ai][1][m][1][e]) * t11; }
                *(u32x4*)(T0 + off) = pack8(r0, r1); }
    }
};
template <class Epi, class Sched, bool ALIGN_EPI = false, bool SP2 = false>
__device__ __forceinline__ void gemm_phase(PG8_LAS unsigned char* lds, const Gemm g, const Sched& S, const Epi& E) {
    int tid_ = threadIdx.x; asm volatile("" : "+v"(tid_));
    const int tid = tid_, wid = __builtin_amdgcn_readfirstlane(tid >> 6), lane = tid & 63, wr = wid >> 2, wc = wid & 3, fr = lane & 15, fq = lane >> 4;
    const int K = g.K, nt = K / BK;
    unsigned voffA[2], voffB[2];
#pragma unroll
    for (int i = 0; i < 2; ++i) { int R, C; stage_rc(tid * 16 + i * 8192, R, C); const int Rb = Epi::PERM ? ((R & ~31) + perm32(R & 31)) : R;
        voffA[i] = (unsigned)(R * g.lda + C) * 2u; voffB[i] = (unsigned)(Rb * K + C) * 2u; }
    const size_t kstep = (size_t)(BK * 2);
    const size_t hstepA = (size_t)HALF * g.lda * 2, hstepB = (size_t)HALF * K * 2;
    const size_t tstepA = 2 * hstepA, tstepB = 2 * hstepB;
    const unsigned ldsw = (unsigned)wid * 1024u;
    const int aoff = lds_byte(wr * 64 + fr, fq * 8), boff = lds_byte(wc * 32 + fr, fq * 8);
#define PG8_SA(b, h) (((b) * 2 + (h)) * HTB)
#define PG8_SB(b, h) ((4 + (b) * 2 + (h)) * HTB)
#define PG8_STAGE(bufoff, gbase, voff) do { _Pragma("unroll") for (int _i = 0; _i < 2; ++_i) \
        __builtin_amdgcn_global_load_lds((const unsigned*)((const char*)(gbase) + (voff)[_i]), (PG8_LAS unsigned*)(lds + (bufoff) + ldsw + _i * 8192), 16, 0, 0); } while (0)
#define PG8_LDA(dst, b, h) do { _Pragma("unroll") for (int m = 0; m < 4; ++m) _Pragma("unroll") for (int k = 0; k < 2; ++k) dst[m][k] = *(const PG8_LAS bf16x8*)(lds + PG8_SA(b, h) + aoff + m * 2048 + k * 1024); } while (0)
#define PG8_LDB(dst, b, h) do { _Pragma("unroll") for (int n = 0; n < 2; ++n) _Pragma("unroll") for (int k = 0; k < 2; ++k) dst[n][k] = *(const PG8_LAS bf16x8*)(lds + PG8_SB(b, h) + boff + n * 2048 + k * 1024); } while (0)
#define PG8_MMA(ai, bj, At, Bt) do { __builtin_amdgcn_s_setprio(1); _Pragma("unroll") for (int m = 0; m < 4; ++m) _Pragma("unroll") for (int n = 0; n < 2; ++n) _Pragma("unroll") for (int k = 0; k < 2; ++k) \
        acc[ai][bj][m][n] = __builtin_amdgcn_mfma_f32_16x16x32_bf16(Bt[n][k], At[m][k], acc[ai][bj][m][n], 0, 0, 0); __builtin_amdgcn_s_setprio(0); } while (0)
#define PG8_WAIT_V(n) asm volatile("s_waitcnt vmcnt(" #n ")" ::: "memory")
#define PG8_WAIT_L(n) asm volatile("s_waitcnt lgkmcnt(" #n ")" ::: "memory")
#define PG8_BAR __builtin_amdgcn_s_barrier()
#define PG8_SCHED __builtin_amdgcn_sched_barrier(0)
    Unit cur, nxt; int ui = 0;
    if (!S.next(0, cur)) return;
    f32x4 acc[2][2][4][2];
#pragma unroll
    for (int a = 0; a < 2; ++a)
#pragma unroll
        for (int b = 0; b < 2; ++b)
#pragma unroll
            for (int m = 0; m < 4; ++m)
#pragma unroll
                for (int n = 0; n < 2; ++n) acc[a][b][m][n] = (f32x4){0.f, 0.f, 0.f, 0.f};
    bf16x8 At[4][2], B0[2][2], B1[2][2];
    const char* cA = (const char*)g.A + (size_t)cur.pm * tstepA; const char* cB = (const char*)g.Bt + (size_t)cur.pn * tstepB;
    S.a_ready(cur);
    if constexpr (SP2) {
        PG8_STAGE(PG8_SB(0, 0), cB, voffB); PG8_STAGE(PG8_SB(0, 1), cB + hstepB, voffB); PG8_STAGE(PG8_SA(0, 0), cA, voffA); PG8_STAGE(PG8_SA(0, 1), cA + hstepA, voffA);
        if (wr == 1) PG8_BAR;
        PG8_WAIT_V(2); PG8_BAR;
        PG8_STAGE(PG8_SB(1, 0), cB + kstep, voffB); PG8_STAGE(PG8_SA(1, 0), cA + kstep, voffA); PG8_STAGE(PG8_SB(1, 1), cB + hstepB + kstep, voffB);
        PG8_WAIT_V(6); PG8_BAR;
    } else {
        PG8_STAGE(PG8_SB(0, 0), cB, voffB); PG8_STAGE(PG8_SA(0, 0), cA, voffA); PG8_STAGE(PG8_SB(0, 1), cB + hstepB, voffB); PG8_STAGE(PG8_SA(0, 1), cA + hstepA, voffA);
        if (wr == 1) PG8_BAR;
        PG8_WAIT_V(4); PG8_BAR;
        PG8_STAGE(PG8_SB(1, 0), cB + kstep, voffB); PG8_STAGE(PG8_SA(1, 0), cA + kstep, voffA); PG8_STAGE(PG8_SB(1, 1), cB + hstepB + kstep, voffB);
        PG8_WAIT_V(6); PG8_BAR;
    }
    for (;;) {
        const bool has_next = S.next(ui + 1, nxt);
        const char* nA = has_next ? (const char*)g.A + (size_t)nxt.pm * tstepA : cA; const char* nB = has_next ? (const char*)g.Bt + (size_t)nxt.pn * tstepB : cB;
        for (int t = 0; t < nt; t += 2) {
            const bool last = (t == nt - 2);
            const char* a1 = cA + (size_t)(t + 1) * kstep;
            const char* a2 = last ? nA : cA + (size_t)(t + 2) * kstep; const char* b2 = last ? nB : cB + (size_t)(t + 2) * kstep;
            const char* a3 = a2 + kstep; const char* b3 = b2 + kstep;
            if (last && has_next) S.a_ready(nxt);
            if constexpr (SP2) {
            PG8_LDB(B0, 0, 0); PG8_LDB(B1, 0, 1); PG8_SCHED; PG8_LDA(At, 0, 0); PG8_STAGE(PG8_SA(1, 1), a1 + hstepA, voffA);
            PG8_WAIT_V(8); PG8_WAIT_L(0); PG8_BAR; PG8_MMA(0, 0, At, B0); PG8_MMA(0, 1, At, B1); PG8_BAR; PG8_SCHED;
            PG8_LDA(At, 0, 1); PG8_STAGE(PG8_SB(0, 0), b2, voffB); PG8_STAGE(PG8_SB(0, 1), b2 + hstepB, voffB); PG8_STAGE(PG8_SA(0, 0), a2, voffA);
            PG8_WAIT_V(8); PG8_WAIT_L(0); PG8_BAR; PG8_MMA(1, 0, At, B0); PG8_MMA(1, 1, At, B1); PG8_BAR; PG8_SCHED;
            PG8_LDB(B0, 1, 0); PG8_LDB(B1, 1, 1); PG8_SCHED; PG8_LDA(At, 1, 0); PG8_STAGE(PG8_SA(0, 1), a2 + hstepA, voffA);
            PG8_WAIT_V(8); PG8_WAIT_L(0); PG8_BAR; PG8_MMA(0, 0, At, B0); PG8_MMA(0, 1, At, B1); PG8_BAR; PG8_SCHED;
            PG8_LDA(At, 1, 1); PG8_STAGE(PG8_SB(1, 0), b3, voffB); PG8_STAGE(PG8_SB(1, 1), b3 + hstepB, voffB); PG8_STAGE(PG8_SA(1, 0), a3, voffA);
            PG8_WAIT_V(8); PG8_WAIT_L(0); PG8_BAR; PG8_MMA(1, 0, At, B0); PG8_MMA(1, 1, At, B1); PG8_BAR; PG8_SCHED;
            } else {
            PG8_LDB(B0, 0, 0); PG8_SCHED; PG8_LDA(At, 0, 0); PG8_STAGE(PG8_SA(1, 1), a1 + hstepA, voffA);
            PG8_WAIT_L(8); PG8_BAR; PG8_WAIT_L(0); PG8_MMA(0, 0, At, B0); PG8_BAR; PG8_SCHED;
            PG8_LDB(B1, 0, 1); PG8_STAGE(PG8_SB(0, 0), b2, voffB);
            PG8_BAR; PG8_WAIT_L(0); PG8_MMA(0, 1, At, B1); PG8_BAR;
            PG8_LDA(At, 0, 1); PG8_STAGE(PG8_SA(0, 0), a2, voffA);
            PG8_BAR; PG8_WAIT_L(0); PG8_MMA(1, 0, At, B0); PG8_BAR; PG8_SCHED;
            PG8_STAGE(PG8_SB(0, 1), b2 + hstepB, voffB);
            PG8_WAIT_V(6); PG8_BAR; PG8_MMA(1, 1, At, B1); PG8_BAR;
            PG8_LDB(B0, 1, 0); PG8_SCHED; PG8_LDA(At, 1, 0); PG8_STAGE(PG8_SA(0, 1), a2 + hstepA, voffA);
            PG8_WAIT_L(8); PG8_BAR; PG8_WAIT_L(0); PG8_MMA(0, 0, At, B0); PG8_BAR; PG8_SCHED;
            PG8_LDB(B1, 1, 1); PG8_STAGE(PG8_SB(1, 0), b3, voffB);
            PG8_BAR; PG8_WAIT_L(0); PG8_MMA(0, 1, At, B1); PG8_BAR;
            PG8_LDA(At, 1, 1); PG8_STAGE(PG8_SA(1, 0), a3, voffA);
            PG8_BAR; PG8_WAIT_L(0); PG8_MMA(1, 0, At, B0); PG8_BAR; PG8_SCHED;
            PG8_STAGE(PG8_SB(1, 1), b3 + hstepB, voffB);
            PG8_WAIT_V(6); PG8_BAR; PG8_MMA(1, 1, At, B1); PG8_BAR;
            }
        }
        if constexpr (ALIGN_EPI) { if (wr == 0) PG8_BAR; }
        if constexpr (!Epi::AFTER_DRAIN) { E(acc, cur, wr, wc, fr, fq); S.done(cur); }
        if (!has_next) break;
#pragma unroll
        for (int a = 0; a < 2; ++a)
#pragma unroll
            for (int b = 0; b < 2; ++b)
#pragma unroll
                for (int m = 0; m < 4; ++m)
#pragma unroll
                    for (int n = 0; n < 2; ++n) acc[a][b][m][n] = (f32x4){0.f, 0.f, 0.f, 0.f};
        cur = nxt; cA = nA; cB = nB; ++ui;
        if constexpr (ALIGN_EPI) { if (wr == 1) PG8_BAR; }
    }
    PG8_WAIT_V(0);
    if constexpr (!ALIGN_EPI) { if (wr == 0) PG8_BAR; }
    PG8_BAR;
    if constexpr (Epi::AFTER_DRAIN) { E.fused(acc, cur, wr, wc, fr, fq, lds, wid, lane); S.done(cur); }
#undef PG8_SA
#undef PG8_SB
#undef PG8_STAGE
#undef PG8_LDA
#undef PG8_LDB
#undef PG8_MMA
#undef PG8_WAIT_V
#undef PG8_WAIT_L
#undef PG8_BAR
#undef PG8_SCHED
}
}

#define LAS __attribute__((address_space(3)))
typedef unsigned short bf16;
typedef float f32x4 __attribute__((ext_vector_type(4)));
typedef float f32x16 __attribute__((ext_vector_type(16)));
typedef short bf16x8 __attribute__((ext_vector_type(8)));
typedef short s16x4 __attribute__((ext_vector_type(4)));
typedef unsigned u32x4 __attribute__((ext_vector_type(4)));
typedef unsigned u32x2 __attribute__((ext_vector_type(2)));

constexpr int D = 1024, MP = 32768, MS = 512, M = MP + MS, FF = 2816, NUP = 5632, NINP = 3840, PIN = 3600, NGATE = 2048, SEQ = 8192, PAST = 2048, INDIM = 5640;
constexpr float EPS = 1e-6f, LOG2E = 1.4426950408889634f;
constexpr size_t MiB = 1u << 20;
constexpr size_t WS_CTL = 0, CTL_BYTES = 64 * 1024;
constexpr size_t WS_GC = 1 * MiB, WS_BE = 2 * MiB;
constexpr size_t WS_W = 3 * MiB;
constexpr size_t W_UP1 = 0, W_DN1 = 11534336, W_IN = 17301504, W_G = 25165824, W_BSB = 29360128, W_BGD = 30408704, W_OUT = 31457280, W_UP2 = 33554432, W_DN2 = 45088768, W_END = 50855936;
constexpr size_t WS_XN = 52 * MiB;
constexpr size_t WS_R1 = 117 * MiB;
constexpr size_t WS_YT = 346 * MiB;
constexpr size_t YT_HALF = (size_t)M * 1024 * 2;
constexpr size_t WS_OR = 476 * MiB;
constexpr size_t WS_ROWSS = 509 * MiB;
constexpr size_t WS_END = WS_ROWSS + (size_t)M * 64;
static_assert(WS_W + W_END <= WS_XN && WS_XN + (size_t)M * 1024 * 2 <= WS_R1 && WS_R1 + (size_t)M * PIN * 2 <= WS_YT && WS_YT + 2 * YT_HALF <= WS_OR && WS_OR + (size_t)M * 512 * 2 <= WS_ROWSS && WS_ROWSS + (size_t)M * 64 <= WS_END, "ws map");
constexpr size_t O_Y = 0, O_KP = (size_t)M * 1024, O_VP = O_KP + 2ull * MP * 512, O_GP = O_VP + 2ull * MP * 512, O_CP = O_GP + 2ull * 4 * 4 * 16384, O_KS = O_CP + 2ull * 4 * 3 * 1536,
                 O_VS = O_KS + 2ull * MS * 512, O_GS = O_VS + 2ull * MS * 512, O_CS = O_GS + 2ull * 8 * 4 * 16384, O_END = O_CS + 2ull * 8 * 3 * 1536;
constexpr int LDS_BYTES = 147456, LDS_Q = LDS_BYTES - 64;
constexpr int NPH = 29;

struct Args { const float* in[19]; float* out; unsigned char* ws; int ph_lo, ph_hi; };
struct Ctx {
    const float *xp, *xs, *cache_k, *cache_v, *state_gdn, *state_conv, *gains, *w1u, *w1d, *win, *convw, *alog, *dtb, *gng, *wbs, *wbg, *wout, *w2u, *w2d;
    float* out; unsigned char* ws; unsigned* ctl; float* rowss; float* gc; float* be; bf16* XN; bf16* P; bf16* ACT; unsigned char* YT; bf16* OR;
    int tid, lane, wave, G, bid;
};
#define LDS_WAIT() asm volatile("s_waitcnt lgkmcnt(0)" ::: "memory")
__device__ __forceinline__ unsigned pk2(float lo, float hi) { return pg8::cvt_pk_bf16(lo, hi); }
__device__ __forceinline__ unsigned short f2b(float x) { return (unsigned short)(pk2(x, 0.f) & 0xffffu); }
__device__ __forceinline__ float bflo(unsigned u) { return __uint_as_float(u << 16); }
__device__ __forceinline__ float bfhi(unsigned u) { return __uint_as_float(u & 0xffff0000u); }
__device__ __forceinline__ float b2f(unsigned short u) { return __uint_as_float((unsigned)u << 16); }
__device__ __forceinline__ float sigm(float x) { return pg8::sigm(x); }
__device__ __forceinline__ float wave_sum(float v) {
#pragma unroll
    for (int o = 1; o < 64; o <<= 1) v += __shfl_xor(v, o);
    return v;
}
__device__ __forceinline__ f32x4 mfma16(bf16x8 a, bf16x8 b, f32x4 c) { return __builtin_amdgcn_mfma_f32_16x16x32_bf16(a, b, c, 0, 0, 0); }
__device__ __forceinline__ f32x16 mfma32(bf16x8 a, bf16x8 b, f32x16 c) { return __builtin_amdgcn_mfma_f32_32x32x16_bf16(a, b, c, 0, 0, 0); }

__device__ __forceinline__ void tr_item(const float* W, int ldw, int src0, int nvalid, int K, bf16* WT, int HW, LAS float* scr, int kb, int nb, int lane) {
    const int k0 = 64 * kb, n0 = 32 * nb, nn = n0 + (lane & 31);
    const bool ok = nn < nvalid; const float* src = W + (size_t)k0 * ldw + src0 + nn;
#pragma unroll 8
    for (int i = 0; i < 32; ++i) { const int kk = 2 * i + (lane >> 5); scr[kk * 33 + (lane & 31)] = ok ? src[(size_t)kk * ldw] : 0.f; }
    LDS_WAIT(); asm volatile("" ::: "memory");
    int drow0 = n0; if (HW) { const int hf = n0 / HW, j = n0 - hf * HW; drow0 = 256 * (j >> 7) + 128 * hf + (j & 127); }
    const int c = lane & 7;
#pragma unroll
    for (int j = 0; j < 4; ++j) { const int n = (lane >> 3) + 8 * j; const LAS float* s = scr + (8 * c) * 33 + n;
        u32x4 o; o.x = pk2(s[0 * 33], s[1 * 33]); o.y = pk2(s[2 * 33], s[3 * 33]); o.z = pk2(s[4 * 33], s[5 * 33]); o.w = pk2(s[6 * 33], s[7 * 33]);
        *(u32x4*)(WT + (size_t)(drow0 + n) * K + k0 + 8 * c) = o; }
    LDS_WAIT(); asm volatile("" ::: "memory");
}
__device__ __forceinline__ void convert_weights(const Ctx& C, int l, LAS unsigned char* lds) {
    LAS float* scr = (LAS float*)(lds + C.wave * 16384);
    const int gw = C.bid * 8 + C.wave, NGW = C.G * 8;
    bf16* Wb = (bf16*)(C.ws + WS_W);
    constexpr int I_UP = 16 * 176, I_DN = 44 * 32, I_IN = 16 * 120, I_G = 16 * 64, I_B = 8 * 32, I_O = 16 * 32;
    constexpr int NITEMS = 2 * I_UP + 2 * I_DN + I_IN + I_G + 2 * I_B + I_O;
    for (int it = gw; it < NITEMS; it += NGW) {
        int r = it;
        if (r < I_UP) { tr_item(C.w1u + (size_t)l * D * NUP, NUP, 0, NUP, D, Wb + W_UP1 / 2, FF, scr, r / 176, r % 176, C.lane); continue; } r -= I_UP;
        if (r < I_UP) { tr_item(C.w2u + (size_t)l * D * NUP, NUP, 0, NUP, D, Wb + W_UP2 / 2, FF, scr, r / 176, r % 176, C.lane); continue; } r -= I_UP;
        if (r < I_DN) { tr_item(C.w1d + (size_t)l * FF * D, D, 0, D, FF, Wb + W_DN1 / 2, 0, scr, r / 32, r % 32, C.lane); continue; } r -= I_DN;
        if (r < I_DN) { tr_item(C.w2d + (size_t)l * FF * D, D, 0, D, FF, Wb + W_DN2 / 2, 0, scr, r / 32, r % 32, C.lane); continue; } r -= I_DN;
        if (r < I_IN) { tr_item(C.win + (size_t)l * D * INDIM, INDIM, 0, 3592, D, Wb + W_IN / 2, 0, scr, r / 120, r % 120, C.lane); continue; } r -= I_IN;
        if (r < I_G) { tr_item(C.win + (size_t)l * D * INDIM, INDIM, 3592, 2048, D, Wb + W_G / 2, 1024, scr, r / 64, r % 64, C.lane); continue; } r -= I_G;
        if (r < I_B) { tr_item(C.wbs + (size_t)l * 512 * D, D, 0, D, 512, Wb + W_BSB / 2, 0, scr, r / 32, r % 32, C.lane); continue; } r -= I_B;
        if (r < I_B) { tr_item(C.wbg + (size_t)l * 512 * D, D, 0, D, 512, Wb + W_BGD / 2, 0, scr, r / 32, r % 32, C.lane); continue; } r -= I_B;
        tr_item(C.wout + (size_t)l * D * D, D, 0, D, D, Wb + W_OUT / 2, 0, scr, r / 32, r % 32, C.lane);
    }
}

__device__ __forceinline__ void row_init_phase(const Ctx& C, const float* g0) {
    const int gw = C.bid * 8 + C.wave, NGW = C.G * 8;
    f32x4 gv[4];
#pragma unroll
    for (int j = 0; j < 4; ++j) gv[j] = *(const f32x4*)(g0 + 4 * C.lane + 256 * j);
    for (int r = gw; r < M; r += NGW) {
        const float* src = (r < MP) ? C.xp + (size_t)r * D : C.xs + (size_t)(r - MP) * D;
        f32x4 v[4]; float s = 0.f;
#pragma unroll
        for (int j = 0; j < 4; ++j) { v[j] = *(const f32x4*)(src + 4 * C.lane + 256 * j); s += (v[j][0] * v[j][0] + v[j][1] * v[j][1]) + (v[j][2] * v[j][2] + v[j][3] * v[j][3]); }
        const float rstd = 1.0f / sqrtf(wave_sum(s) * (1.f / D) + EPS);
        float* xo = C.out + O_Y + (size_t)r * D; bf16* xn = C.XN + (size_t)r * D;
#pragma unroll
        for (int j = 0; j < 4; ++j) { *(f32x4*)(xo + 4 * C.lane + 256 * j) = v[j];
            u32x2 w; w.x = pk2(v[j][0] * rstd * gv[j][0], v[j][1] * rstd * gv[j][1]); w.y = pk2(v[j][2] * rstd * gv[j][2], v[j][3] * rstd * gv[j][3]);
            *(u32x2*)(xn + 4 * C.lane + 256 * j) = w; }
    }
}
__device__ __forceinline__ void thin_phase(const Ctx& C, const bf16* Y, float scale, const float* gpost, const float* gnext) {
    const int gw = C.bid * 8 + C.wave, NGW = C.G * 8;
    f32x4 gp[4], gn[4];
#pragma unroll
    for (int j = 0; j < 4; ++j) { gp[j] = *(const f32x4*)(gpost + 4 * C.lane + 256 * j); gn[j] = gnext ? *(const f32x4*)(gnext + 4 * C.lane + 256 * j) : (f32x4){0.f, 0.f, 0.f, 0.f}; }
    for (int r = gw; r < M; r += NGW) {
        float* xr = C.out + O_Y + (size_t)r * D; const bf16* yr = Y + (size_t)r * D;
        float pv = (C.lane < 16) ? C.rowss[(size_t)r * 16 + C.lane] : 0.f;
        pv += __shfl_xor(pv, 8); pv += __shfl_xor(pv, 4); pv += __shfl_xor(pv, 2); pv += __shfl_xor(pv, 1);
        const float ss = __shfl(pv, 0);
        const float rs = scale / sqrtf(ss * (1.f / D) + EPS);
        f32x4 v[4]; float s = 0.f;
#pragma unroll
        for (int j = 0; j < 4; ++j) { v[j] = *(const f32x4*)(xr + 4 * C.lane + 256 * j); const u32x2 y = *(const u32x2*)(yr + 4 * C.lane + 256 * j);
            v[j][0] += bflo(y.x) * rs * gp[j][0]; v[j][1] += bfhi(y.x) * rs * gp[j][1]; v[j][2] += bflo(y.y) * rs * gp[j][2]; v[j][3] += bfhi(y.y) * rs * gp[j][3];
            s += (v[j][0] * v[j][0] + v[j][1] * v[j][1]) + (v[j][2] * v[j][2] + v[j][3] * v[j][3]); }
        const float rstd = 1.0f / sqrtf(wave_sum(s) * (1.f / D) + EPS);
        bf16* xn = C.XN + (size_t)r * D;
#pragma unroll
        for (int j = 0; j < 4; ++j) { *(f32x4*)(xr + 4 * C.lane + 256 * j) = v[j];
            if (gnext) { u32x2 w; w.x = pk2(v[j][0] * rstd * gn[j][0], v[j][1] * rstd * gn[j][1]); w.y = pk2(v[j][2] * rstd * gn[j][2], v[j][3] * rstd * gn[j][3]);
                *(u32x2*)(xn + 4 * C.lane + 256 * j) = w; } }
    }
}
__device__ __forceinline__ void gdn_norm_phase(const Ctx& C, int l) {
    const int gw = C.bid * 8 + C.wave, NGW = C.G * 8;
    const float* gain = C.gng + l * 128 + (C.lane & 15) * 8;
    const f32x4 g0 = *(const f32x4*)gain, g1 = *(const f32x4*)(gain + 4);
    for (int r = gw; r < M; r += NGW) {
        const u32x4 ov = *(const u32x4*)(C.OR + (size_t)r * 512 + C.lane * 8); bf16* zp = C.P + (size_t)r * PIN + 3072 + C.lane * 8; const u32x4 zv = *(const u32x4*)zp;
        float o[8], z[8];
#pragma unroll
        for (int e = 0; e < 4; ++e) { o[2 * e] = bflo(ov[e]); o[2 * e + 1] = bfhi(ov[e]); z[2 * e] = bflo(zv[e]); z[2 * e + 1] = bfhi(zv[e]); }
        float ss = 0.f;
#pragma unroll
        for (int e = 0; e < 8; ++e) ss += o[e] * o[e];
        ss += __shfl_xor(ss, 1); ss += __shfl_xor(ss, 2); ss += __shfl_xor(ss, 4); ss += __shfl_xor(ss, 8);
        const float rstd = 1.0f / sqrtf(ss * (1.f / 128.f) + EPS);
        f32x4 r0, r1;
#pragma unroll
        for (int e = 0; e < 4; ++e) { r0[e] = o[e] * rstd * g0[e] * z[e] * sigm(z[e]); r1[e] = o[4 + e] * rstd * g1[e] * z[4 + e] * sigm(z[4 + e]); }
        *(u32x4*)zp = pg8::pack8(r0, r1);
    }
}

constexpr int PRE_U = 0, PRE_QN = 65536, PRE_KN = 82944, PRE_AF = 100352, PRE_RN = 117760, PRE_GC = 118272, PRE_BE = 118528;
__device__ __forceinline__ void gdn_pre_unit(const Ctx& C, int l, int n, int h, unsigned char* lds) {
    const int tid = C.tid, lane = C.lane, wave = C.wave;
    float* U = (float*)(lds + PRE_U); bf16* QN = (bf16*)(lds + PRE_QN); bf16* KN = (bf16*)(lds + PRE_KN); float* AF = (float*)(lds + PRE_AF);
    float* RN = (float*)(lds + PRE_RN); float* GC = (float*)(lds + PRE_GC); float* BE = (float*)(lds + PRE_BE);
    const int row0 = n * 64; const bool isS = n >= 512; const int sb = n - 512;
    const bool seq_first = isS ? true : ((n & 127) == 0); const bool seq_last = isS ? true : ((n & 127) == 127);
    unsigned char* rec = C.YT + (size_t)(n * 4 + h) * 65536;
    if (tid < 384) {
        const int cgp = tid % 48, rs = tid / 48, part = cgp >> 4, c8 = (cgp & 15) * 8, cc = part * 512 + h * 128 + c8;
        float w[4][8];
#pragma unroll
        for (int i = 0; i < 4; ++i) { const f32x4 a = *(const f32x4*)(C.convw + (size_t)(l * 4 + i) * 1536 + cc), b = *(const f32x4*)(C.convw + (size_t)(l * 4 + i) * 1536 + cc + 4);
#pragma unroll
            for (int e = 0; e < 4; ++e) { w[i][e] = a[e]; w[i][4 + e] = b[e]; } }
        float win[3][8];
#pragma unroll
        for (int i = 0; i < 3; ++i) { const int rr = 8 * rs - 3 + i;
            if (rr >= 0 || !seq_first) { const u32x4 v = *(const u32x4*)(C.P + (size_t)(row0 + rr) * PIN + 1536 + cc);
#pragma unroll
                for (int e = 0; e < 4; ++e) { win[i][2 * e] = bflo(v[e]); win[i][2 * e + 1] = bfhi(v[e]); } }
            else if (isS) { const float* sc = C.state_conv + ((size_t)(l * 8 + sb) * 3 + (3 + rr)) * 1536 + cc; const f32x4 a = *(const f32x4*)sc, b = *(const f32x4*)(sc + 4);
#pragma unroll
                for (int e = 0; e < 4; ++e) { win[i][e] = a[e]; win[i][4 + e] = b[e]; } }
            else {
#pragma unroll
                for (int e = 0; e < 8; ++e) win[i][e] = 0.f; } }
#pragma unroll
        for (int rr = 0; rr < 8; ++rr) { const int r = 8 * rs + rr; const u32x4 v = *(const u32x4*)(C.P + (size_t)(row0 + r) * PIN + 1536 + cc);
            float cur[8], y[8];
#pragma unroll
            for (int e = 0; e < 4; ++e) { cur[2 * e] = bflo(v[e]); cur[2 * e + 1] = bfhi(v[e]); }
#pragma unroll
            for (int e = 0; e < 8; ++e) { const float t = win[0][e] * w[0][e] + win[1][e] * w[1][e] + win[2][e] * w[2][e] + cur[e] * w[3][e]; y[e] = t * sigm(t);
                win[0][e] = win[1][e]; win[1][e] = win[2][e]; win[2][e] = cur[e]; }
            if (part < 2) { *(f32x4*)(U + r * 256 + part * 128 + c8) = (f32x4){y[0], y[1], y[2], y[3]}; *(f32x4*)(U + r * 256 + part * 128 + c8 + 4) = (f32x4){y[4], y[5], y[6], y[7]}; }
            else { u32x4 o; o.x = pk2(y[0], y[1]); o.y = pk2(y[2], y[3]); o.z = pk2(y[4], y[5]); o.w = pk2(y[6], y[7]); *(u32x4*)(rec + 32768 + (size_t)(r * 128 + c8) * 2) = o; }
            if (seq_last && r >= 61) { float* o = C.out + (isS ? O_CS + ((size_t)(l * 8 + sb) * 3 + (r - 61)) * 1536 : O_CP + ((size_t)(l * 4 + (n >> 7)) * 3 + (r - 61)) * 1536) + cc;
                *(f32x4*)o = (f32x4){cur[0], cur[1], cur[2], cur[3]}; *(f32x4*)(o + 4) = (f32x4){cur[4], cur[5], cur[6], cur[7]}; }
        }
    } else if (wave == 7) {
        const float bl = b2f(C.P[(size_t)(row0 + lane) * PIN + 3584 + h]), al = b2f(C.P[(size_t)(row0 + lane) * PIN + 3588 + h]);
        const float beta = sigm(bl); const float xa = al + C.dtb[l * 4 + h];
        const float sp = fmaxf(xa, 0.f) + log1pf(expf(-fabsf(xa)));
        float g = -expf(C.alog[l * 4 + h]) * sp;
#pragma unroll
        for (int o = 1; o < 64; o <<= 1) { const float t = __shfl_up(g, o); if (lane >= o) g += t; }
        GC[lane] = g; BE[lane] = beta; C.gc[(size_t)(row0 + lane) * 4 + h] = g; C.be[(size_t)(row0 + lane) * 4 + h] = beta;
    }
    __syncthreads();
    { const int r = tid >> 3, sub = tid & 7, part = sub >> 2, qt = sub & 3; const float* u = U + r * 256 + part * 128 + 32 * qt; f32x4 v[8]; float ss = 0.f;
#pragma unroll
        for (int i = 0; i < 8; ++i) { v[i] = *(const f32x4*)(u + 4 * i); ss += (v[i][0] * v[i][0] + v[i][1] * v[i][1]) + (v[i][2] * v[i][2] + v[i][3] * v[i][3]); }
        ss += __shfl_xor(ss, 1); ss += __shfl_xor(ss, 2);
        float rn = 1.0f / sqrtf(ss + EPS); if (part == 0) rn *= 0.08838834764831845f;
        bf16* dl = (part ? KN : QN) + r * 136 + 32 * qt; unsigned char* dg = rec + (part ? 16384 : 0) + (size_t)(r * 128 + 32 * qt) * 2;
#pragma unroll
        for (int i = 0; i < 4; ++i) { const u32x4 o = pg8::pack8(v[2 * i] * rn, v[2 * i + 1] * rn); *(u32x4*)(dl + 8 * i) = o; *(u32x4*)(dg + 16 * i) = o; } }
    __syncthreads();
    { const int p = wave >> 2, mt = wave & 3, lc = lane & 15, lq = lane >> 4; const bf16* Ab = (p ? QN : KN) + (16 * mt + lc) * 136 + 8 * lq;
        bf16x8 af[4];
#pragma unroll
        for (int ks = 0; ks < 4; ++ks) af[ks] = *(const bf16x8*)(Ab + 32 * ks);
#pragma unroll
        for (int nt = 0; nt < 4; ++nt) { f32x4 acc = {0.f, 0.f, 0.f, 0.f};
            if (nt <= mt) {
#pragma unroll
                for (int ks = 0; ks < 4; ++ks) acc = mfma16(af[ks], *(const bf16x8*)(KN + (16 * nt + lc) * 136 + 32 * ks + 8 * lq), acc); }
            const int j = 16 * nt + lc; const float gj = GC[j];
#pragma unroll
            for (int rg = 0; rg < 4; ++rg) { const int i = 16 * mt + 4 * lq + rg; const float dec = (i >= j) ? __expf(GC[i] - gj) : 0.f;
                if (p == 0) AF[i * 68 + j] = (i > j) ? BE[i] * acc[rg] * dec : 0.f;
                else *(bf16*)(rec + 57344 + (size_t)(i * 64 + j) * 2) = f2b((i >= j) ? acc[rg] * dec : 0.f); } } }
    __syncthreads();
    if (wave == 0) { float* X = U;
#pragma unroll 1
        for (int i = 0; i < 64; ++i) { float s0 = (lane == i) ? 1.f : 0.f, s1 = 0.f, s2 = 0.f, s3 = 0.f; const float* ar = AF + i * 68; int j = 0;
#pragma unroll 2
            for (; j + 4 <= i; j += 4) { const f32x4 a = *(const f32x4*)(ar + j);
                s0 -= a[0] * X[(j + 0) * 64 + lane]; s1 -= a[1] * X[(j + 1) * 64 + lane]; s2 -= a[2] * X[(j + 2) * 64 + lane]; s3 -= a[3] * X[(j + 3) * 64 + lane]; }
            for (; j < i; ++j) s0 -= ar[j] * X[j * 64 + lane];
            const float x = (s0 + s1) + (s2 + s3); X[i * 64 + lane] = x;
            *(bf16*)(rec + 49152 + (size_t)(i * 64 + lane) * 2) = f2b(x); } }
    __syncthreads();
}

constexpr int SC_SET = 53248, SC_KN = 0, SC_QN = 17408, SC_TI = 34816, SC_QK = 44032, SC_ST = 2 * SC_SET, SC_STSZ = 8704, SC_DT = SC_ST + 2 * SC_STSZ, SC_VN = SC_DT + 4608, SC_VS = SC_VN + 4608;
static_assert(SC_VS + 4608 <= LDS_Q, "scan LDS");
__device__ __forceinline__ void scan_unit(const Ctx& C, int l, int isS, int b, int h, int sl, unsigned char* lds) {
    const int tid = C.tid, lane = C.lane, wave = C.wave, lc = lane & 15, lq = lane >> 4, mt = wave & 1, nt = wave >> 1;
    const int nch = isS ? 1 : 128, n0 = isS ? 512 + b : 128 * b, dv0 = 32 * sl;
    f32x4 S[2];
#pragma unroll
    for (int t = 0; t < 2; ++t) { const int dk = 16 * (2 * nt + t) + lc;
        S[t] = isS ? *(const f32x4*)(C.state_gdn + ((size_t)((l * 8 + b) * 4 + h) * 128 + dk) * 128 + dv0 + 16 * mt + 4 * lq) : (f32x4){0.f, 0.f, 0.f, 0.f};
#pragma unroll
        for (int rg = 0; rg < 4; ++rg) *(bf16*)(lds + SC_ST + (16 * mt + 4 * lq + rg) * 272 + (16 * (2 * nt + t) + lc) * 2) = f2b(S[t][rg]); }
    u32x4 pf[6];
#define SC_LOAD(n_) do { const unsigned char* rec_ = C.YT + (size_t)((n_) * 4 + h) * 65536; \
        pf[0] = *(const u32x4*)(rec_ + 16384 + (size_t)tid * 16); pf[1] = *(const u32x4*)(rec_ + 16384 + (size_t)(tid + 512) * 16); \
        pf[2] = *(const u32x4*)(rec_ + (size_t)tid * 16); pf[3] = *(const u32x4*)(rec_ + (size_t)(tid + 512) * 16); \
        pf[4] = *(const u32x4*)(rec_ + 49152 + (size_t)tid * 16); pf[5] = *(const u32x4*)(rec_ + 57344 + (size_t)tid * 16); } while (0)
#define SC_STORE(set_) do { unsigned char* s_ = lds + (set_) * SC_SET; \
        *(u32x4*)(s_ + SC_KN + (tid >> 4) * 272 + (tid & 15) * 16) = pf[0]; *(u32x4*)(s_ + SC_KN + (32 + (tid >> 4)) * 272 + (tid & 15) * 16) = pf[1]; \
        *(u32x4*)(s_ + SC_QN + (tid >> 4) * 272 + (tid & 15) * 16) = pf[2]; *(u32x4*)(s_ + SC_QN + (32 + (tid >> 4)) * 272 + (tid & 15) * 16) = pf[3]; \
        *(u32x4*)(s_ + SC_TI + (tid >> 3) * 144 + (tid & 7) * 16) = pf[4]; *(u32x4*)(s_ + SC_QK + (tid >> 3) * 144 + (tid & 7) * 16) = pf[5]; } while (0)
    SC_LOAD(n0); SC_STORE(0);
    __syncthreads();
    for (int c = 0; c < nch; ++c) {
        const int cur = c & 1, n = n0 + c, row0 = n * 64, i = 16 * nt + lc;
        const unsigned char* set = lds + cur * SC_SET; const unsigned char* STc = lds + SC_ST + cur * SC_STSZ; unsigned char* STn = lds + SC_ST + (cur ^ 1) * SC_STSZ;
        const unsigned char* rec = C.YT + (size_t)(n * 4 + h) * 65536;
        if (c + 1 < nch) SC_LOAD(n + 1);
        const float gi = C.gc[(size_t)(row0 + i) * 4 + h], bi = C.be[(size_t)(row0 + i) * 4 + h], gl = C.gc[(size_t)(row0 + 63) * 4 + h];
        const u32x2 vv = *(const u32x2*)(rec + 32768 + (size_t)(i * 128 + dv0 + 16 * mt + 4 * lq) * 2);
        const float eg = __expf(gi), ek = __expf(gl - gi), cd = __expf(gl);
        bf16x8 sa[4]; f32x4 acc = {0.f, 0.f, 0.f, 0.f};
#pragma unroll
        for (int ks = 0; ks < 4; ++ks) { sa[ks] = *(const bf16x8*)(STc + (16 * mt + lc) * 272 + (32 * ks + 8 * lq) * 2);
            acc = mfma16(sa[ks], *(const bf16x8*)(set + SC_KN + (16 * nt + lc) * 272 + (32 * ks + 8 * lq) * 2), acc); }
        { const float v0 = bflo(vv.x), v1 = bfhi(vv.x), v2 = bflo(vv.y), v3 = bfhi(vv.y); unsigned char* d = lds + SC_DT + (16 * mt + 4 * lq) * 144 + i * 2;
            *(bf16*)(d) = f2b(bi * (v0 - acc[0] * eg)); *(bf16*)(d + 144) = f2b(bi * (v1 - acc[1] * eg)); *(bf16*)(d + 288) = f2b(bi * (v2 - acc[2] * eg)); *(bf16*)(d + 432) = f2b(bi * (v3 - acc[3] * eg)); }
        __syncthreads();
        f32x4 vn = {0.f, 0.f, 0.f, 0.f};
#pragma unroll
        for (int ks = 0; ks < 2; ++ks) vn = mfma16(*(const bf16x8*)(lds + SC_DT + (16 * mt + lc) * 144 + (32 * ks + 8 * lq) * 2), *(const bf16x8*)(set + SC_TI + (16 * nt + lc) * 144 + (32 * ks + 8 * lq) * 2), vn);
        { unsigned char* d = lds + SC_VN + (16 * mt + 4 * lq) * 144 + i * 2; unsigned char* e = lds + SC_VS + (16 * mt + 4 * lq) * 144 + i * 2;
#pragma unroll
            for (int rg = 0; rg < 4; ++rg) { *(bf16*)(d + 144 * rg) = f2b(vn[rg]); *(bf16*)(e + 144 * rg) = f2b(vn[rg] * ek); } }
        __syncthreads();
        { f32x4 a1 = {0.f, 0.f, 0.f, 0.f}, a2 = {0.f, 0.f, 0.f, 0.f};
#pragma unroll
            for (int ks = 0; ks < 4; ++ks) a1 = mfma16(sa[ks], *(const bf16x8*)(set + SC_QN + (16 * nt + lc) * 272 + (32 * ks + 8 * lq) * 2), a1);
#pragma unroll
            for (int ks = 0; ks < 2; ++ks) a2 = mfma16(*(const bf16x8*)(lds + SC_VN + (16 * mt + lc) * 144 + (32 * ks + 8 * lq) * 2), *(const bf16x8*)(set + SC_QK + (16 * nt + lc) * 144 + (32 * ks + 8 * lq) * 2), a2);
            u32x2 o; o.x = pk2(a1[0] * eg + a2[0], a1[1] * eg + a2[1]); o.y = pk2(a1[2] * eg + a2[2], a1[3] * eg + a2[3]);
            *(u32x2*)(C.OR + (size_t)(row0 + i) * 512 + h * 128 + dv0 + 16 * mt + 4 * lq) = o; }
#pragma unroll
        for (int t = 0; t < 2; ++t) { const int dk = 16 * (2 * nt + t) + lc; S[t] = S[t] * cd;
#pragma unroll
            for (int ks = 0; ks < 2; ++ks) { bf16x8 kb;
#pragma unroll
                for (int j = 0; j < 8; ++j) kb[j] = (short)*(const bf16*)(set + SC_KN + (32 * ks + 8 * lq + j) * 272 + dk * 2);
                S[t] = mfma16(*(const bf16x8*)(lds + SC_VS + (16 * mt + lc) * 144 + (32 * ks + 8 * lq) * 2), kb, S[t]); }
#pragma unroll
            for (int rg = 0; rg < 4; ++rg) *(bf16*)(STn + (16 * mt + 4 * lq + rg) * 272 + dk * 2) = f2b(S[t][rg]); }
        if (c + 1 < nch) SC_STORE(cur ^ 1);
        __syncthreads();
    }
#undef SC_LOAD
#undef SC_STORE
    float* so = C.out + (isS ? O_GS + (size_t)((l * 8 + b) * 4 + h) * 16384 : O_GP + (size_t)((l * 4 + b) * 4 + h) * 16384);
#pragma unroll
    for (int t = 0; t < 2; ++t) *(f32x4*)(so + (size_t)(16 * (2 * nt + t) + lc) * 128 + dv0 + 16 * mt + 4 * lq) = S[t];
}

constexpr int AT_K = 0, AT_V = 8192, AT_FL = 16384;
__device__ __forceinline__ int crow(int r, int hi) { return (r & 3) + 8 * (r >> 2) + 4 * hi; }
typedef short v4i16_t __attribute__((ext_vector_type(4)));
__device__ __forceinline__ s16x4 vtr(const LAS unsigned char* p) { return __builtin_bit_cast(s16x4, __builtin_amdgcn_ds_read_tr16_b64_v4i16((LAS v4i16_t*)p)); }
__device__ __forceinline__ void sb_block(f32x16& p, int keybase, int qp, bool mask, float& carry, int hi) {
    float G[4];
#pragma unroll
    for (int g = 0; g < 4; ++g) { float kp[4], be[4];
#pragma unroll
        for (int e = 0; e < 4; ++e) { const float z = p[4 * g + e]; const float ex = __builtin_amdgcn_exp2f(-fabsf(z) * (0.125f * LOG2E)); const float r = __builtin_amdgcn_rcpf(1.f + ex); const float er = ex * r;
            const bool pos = z >= 0.f; float bt = pos ? r : er, kv = pos ? er : r;
            if (mask) { const int key = keybase + 8 * g + 4 * hi + e; if (key >= qp) { bt = 0.f; kv = 1.f; } }
            kp[e] = kv; be[e] = bt; }
        const float s2 = kp[3], s1 = kp[3] * kp[2], s0 = s1 * kp[1]; G[g] = s0 * kp[0];
        p[4 * g + 3] = be[3]; p[4 * g + 2] = be[2] * s2; p[4 * g + 1] = be[1] * s1; p[4 * g] = be[0] * s0; }
    float run = carry;
#pragma unroll
    for (int g = 3; g >= 0; --g) { const float gp = __shfl_xor(G[g], 32); const float aft = hi ? run : run * gp;
#pragma unroll
        for (int e = 0; e < 4; ++e) p[4 * g + e] *= aft;
        run *= G[g] * gp; }
    carry = run;
}
__device__ __forceinline__ void attn_unit(const Ctx& C, int l, int isS, int b, int h, int qb, unsigned char* lds) {
    const int tid = C.tid, lane = C.lane, wid = C.wave, r32 = lane & 31, hi = lane >> 5;
    bf16* P = C.P;
    const int q_row0 = isS ? MP + 64 * b : b * SEQ + 256 * qb, qpos0 = isS ? PAST : 256 * qb, nq = isS ? 64 : 256;
    const int kv_pos0 = isS ? PAST : 0, kv_row0 = isS ? MP + 64 * b : b * SEQ;
    const float* Kc = C.cache_k + (size_t)(l * 8 + b) * PAST * 512 + h * 64; const float* Vc = C.cache_v + (size_t)(l * 8 + b) * PAST * 512 + h * 64;
    const int T_top = (qpos0 + nq - 2) >> 6; const bool wact = 32 * wid < nq; const int wtop = (qpos0 + 32 * wid + 30) >> 6;
    bf16x8 qr[4];
#pragma unroll
    for (int d0 = 0; d0 < 4; ++d0) qr[d0] = wact ? *(const bf16x8*)(P + (size_t)(q_row0 + 32 * wid + r32) * PIN + h * 64 + d0 * 16 + hi * 8) : (bf16x8){0, 0, 0, 0, 0, 0, 0, 0};
    f32x16 o[2]; o[0] = f32x16{}; o[1] = f32x16{};
    float carry = 1.f;
    u32x4 kreg, vreg;
#define AT_LOAD(t_) do { const int pos0_ = 64 * (t_); \
        if (pos0_ >= kv_pos0) { kreg = *(const u32x4*)(P + (size_t)(kv_row0 + pos0_ - kv_pos0 + lane) * PIN + 512 + h * 64 + wid * 8); \
                                vreg = *(const u32x4*)(P + (size_t)(kv_row0 + pos0_ - kv_pos0 + (tid >> 3)) * PIN + 1024 + h * 64 + (tid & 7) * 8); } \
        else { const float* kp_ = Kc + (size_t)(pos0_ + lane) * 512 + wid * 8; kreg = pg8::pack8(*(const f32x4*)kp_, *(const f32x4*)(kp_ + 4)); \
               const float* vp_ = Vc + (size_t)(pos0_ + (tid >> 3)) * 512 + (tid & 7) * 8; vreg = pg8::pack8(*(const f32x4*)vp_, *(const f32x4*)(vp_ + 4)); } } while (0)
    AT_LOAD(T_top);
    const LAS unsigned char* l3 = (const LAS unsigned char*)lds;
    const int voff = ((lane >> 4) & 1) * 32 + (lane & 3) * 8 + (4 * hi + ((lane & 15) >> 2)) * 64;
    float* fl = (float*)(lds + AT_FL);
    for (int t = T_top; t >= 0; --t) {
        *(u32x4*)(lds + AT_K + wid * 1024 + lane * 16) = kreg;
        *(u32x4*)(lds + AT_V + ((tid & 7) >> 2) * 4096 + (tid >> 3) * 64 + (tid & 3) * 16) = vreg;
        __syncthreads();
        if (t > 0) AT_LOAD(t - 1);
        if (wact && t <= wtop) {
            f32x16 p0 = f32x16{}, p1 = f32x16{};
#pragma unroll
            for (int d0 = 0; d0 < 4; ++d0) { const bf16x8 k0 = *(const bf16x8*)(lds + AT_K + (2 * d0 + hi) * 1024 + r32 * 16), k1 = *(const bf16x8*)(lds + AT_K + (2 * d0 + hi) * 1024 + r32 * 16 + 512);
                p0 = mfma32(k0, qr[d0], p0); p1 = mfma32(k1, qr[d0], p1); }
            const int qp = qpos0 + 32 * wid + r32; const bool mask = (64 * t + 63 >= qpos0 + 32 * wid);
            sb_block(p1, 64 * t + 32, qp, mask, carry, hi);
            sb_block(p0, 64 * t, qp, mask, carry, hi);
            bf16x8 pw[4];
            { u32x4 w; w.x = pk2(p0[0], p0[1]); w.y = pk2(p0[2], p0[3]); w.z = pk2(p0[4], p0[5]); w.w = pk2(p0[6], p0[7]); pw[0] = __builtin_bit_cast(bf16x8, w);
              w.x = pk2(p0[8], p0[9]); w.y = pk2(p0[10], p0[11]); w.z = pk2(p0[12], p0[13]); w.w = pk2(p0[14], p0[15]); pw[1] = __builtin_bit_cast(bf16x8, w);
              w.x = pk2(p1[0], p1[1]); w.y = pk2(p1[2], p1[3]); w.z = pk2(p1[4], p1[5]); w.w = pk2(p1[6], p1[7]); pw[2] = __builtin_bit_cast(bf16x8, w);
              w.x = pk2(p1[8], p1[9]); w.y = pk2(p1[10], p1[11]); w.z = pk2(p1[12], p1[13]); w.w = pk2(p1[14], p1[15]); pw[3] = __builtin_bit_cast(bf16x8, w); }
#pragma unroll
            for (int d0 = 0; d0 < 2; ++d0)
#pragma unroll
                for (int s = 0; s < 4; ++s) { const s16x4 a = vtr(l3 + AT_V + d0 * 4096 + s * 1024 + voff), c2 = vtr(l3 + AT_V + d0 * 4096 + s * 1024 + 512 + voff);
                    const bf16x8 vf = (bf16x8){a[0], a[1], a[2], a[3], c2[0], c2[1], c2[2], c2[3]};
                    o[d0] = mfma32(pw[s], vf, o[d0]); }
        }
        { float cm = wact ? carry : 0.f;
#pragma unroll
          for (int of = 1; of < 64; of <<= 1) cm = fmaxf(cm, __shfl_xor(cm, of));
          if (lane == 0) fl[wid] = cm; }
        __syncthreads();
        float mx = 0.f;
#pragma unroll
        for (int w = 0; w < 8; ++w) mx = fmaxf(mx, fl[w]);
        if (mx < 1e-30f) break;
    }
#undef AT_LOAD
    if (wact) {
#pragma unroll
        for (int d0 = 0; d0 < 2; ++d0)
#pragma unroll
            for (int r = 0; r < 16; ++r) P[(size_t)(q_row0 + 32 * wid + crow(r, hi)) * PIN + h * 64 + 32 * d0 + r32] = f2b(o[d0][r]);
    }
    __syncthreads();
}

#ifndef PHMASK
#define PHMASK 0xffff
#endif
#define HAS(k) (((PHMASK) >> (k)) & 1)
#define MKCTX Ctx C; C.xp = ap->in[0]; C.xs = ap->in[1]; C.cache_k = ap->in[2]; C.cache_v = ap->in[3]; C.state_gdn = ap->in[4]; C.state_conv = ap->in[5]; C.gains = ap->in[6]; C.w1u = ap->in[7]; C.w1d = ap->in[8]; C.win = ap->in[9]; C.convw = ap->in[10]; C.alog = ap->in[11]; C.dtb = ap->in[12]; C.gng = ap->in[13]; C.wbs = ap->in[14]; C.wbg = ap->in[15]; C.wout = ap->in[16]; C.w2u = ap->in[17]; C.w2d = ap->in[18]; C.out = out_; C.ws = ws_; C.ctl = (unsigned*)(ws_ + WS_CTL); C.rowss = (float*)(ws_ + WS_ROWSS); C.gc = (float*)(ws_ + WS_GC); C.be = (float*)(ws_ + WS_BE); C.XN = (bf16*)(ws_ + WS_XN); C.P = (bf16*)(ws_ + WS_R1); C.ACT = (bf16*)(ws_ + WS_R1); C.YT = ws_ + WS_YT; C.OR = (bf16*)(ws_ + WS_OR); C.tid = tid_; C.lane = C.tid & 63; C.wave = __builtin_amdgcn_readfirstlane(C.tid >> 6); C.G = gridDim.x; C.bid = bid_; LAS unsigned char* lds3 = (LAS unsigned char*)lds; bf16* Wb = (bf16*)(ws_ + WS_W); bf16* Y0 = (bf16*)C.YT; bf16* Y1 = (bf16*)(C.YT + YT_HALF);
template <int ph> __device__ __forceinline__ void run_phase(unsigned char* lds) {
    constexpr int l = (ph - 1) / 14, q = (ph - 1) % 14;
    const __attribute__((address_space(4))) Args* ap = (const __attribute__((address_space(4))) Args*)__builtin_amdgcn_kernarg_segment_ptr();
    int tid_ = threadIdx.x; int bid_ = blockIdx.x;
    asm volatile("" : "+s"(ap), "+v"(tid_), "+s"(bid_));
    unsigned char* ws_ = ap->ws; float* out_ = ap->out;
    LAS unsigned char* lds3 = (LAS unsigned char*)lds;
    bf16* Wb = (bf16*)(ws_ + WS_W); bf16* Y0 = (bf16*)(ws_ + WS_YT); bf16* Y1 = (bf16*)(ws_ + WS_YT + YT_HALF);
        if constexpr (HAS(0) && ph == 0) { MKCTX; convert_weights(C, 0, lds3); row_init_phase(C, C.gains); }
        else if constexpr (HAS(1) && (q == 0 || q == 11)) { MKCTX;
            pg8::Gemm g{C.XN, Wb + (q == 0 ? W_UP1 : W_UP2) / 2, M, NUP, D, D}; pg8::StaticOrder S; S.init(M, NUP, C.G, C.bid);
            pg8::EpiSwiglu E{C.ACT, FF}; pg8::gemm_phase<pg8::EpiSwiglu, pg8::StaticOrder, true, true>(lds3, g, S, E);
        } else if constexpr (HAS(2) && (q == 1 || q == 12 || q == 9)) { MKCTX;
            const bf16* A = (q == 9) ? Y0 : C.ACT; const int K = (q == 9) ? D : FF; bf16* O = (q == 9) ? Y1 : Y0;
            pg8::Gemm g{A, Wb + (q == 1 ? W_DN1 : q == 12 ? W_DN2 : W_OUT) / 2, M, D, K, K}; pg8::StaticOrder S; S.init(M, D, C.G, C.bid);
            pg8::EpiYss E{O, C.rowss}; pg8::gemm_phase<pg8::EpiYss, pg8::StaticOrder, true, true>(lds3, g, S, E);
        } else if constexpr (HAS(3) && q == 2) { MKCTX; const float* gl = C.gains + (size_t)l * 6 * D; thin_phase(C, Y0, 0.5f, gl + 1 * D, gl + 2 * D); }
        else if constexpr (HAS(3) && q == 10) { MKCTX; const float* gl = C.gains + (size_t)l * 6 * D; thin_phase(C, Y1, 1.0f, gl + 3 * D, gl + 4 * D); }
        else if constexpr (HAS(3) && q == 13) { MKCTX; const float* gl = C.gains + (size_t)l * 6 * D; if (l == 0) convert_weights(C, 1, lds3); thin_phase(C, Y0, 0.5f, gl + 5 * D, l == 0 ? gl + 6 * D : nullptr); }
        else if constexpr (HAS(4) && q == 3) { MKCTX;
            pg8::Gemm g{C.XN, Wb + W_IN / 2, M, NINP, D, D}; pg8::StaticOrder S; S.init(M, NINP, C.G, C.bid);
            pg8::EpiIn E{C.P, PIN, C.out + O_KP + (size_t)l * MP * 512, C.out + O_VP + (size_t)l * MP * 512, C.out + O_KS + (size_t)l * MS * 512, C.out + O_VS + (size_t)l * MS * 512, MP};
            pg8::gemm_phase<pg8::EpiIn, pg8::StaticOrder, true, true>(lds3, g, S, E);
        } else if constexpr (HAS(5) && q == 4) { MKCTX; for (int u = C.bid; u < 520 * 4; u += C.G) gdn_pre_unit(C, l, u >> 2, u & 3, lds); }
        else if constexpr ((HAS(6) || HAS(7)) && q == 5) { MKCTX;
            unsigned* qw = C.ctl + 64 * (1 + l); volatile unsigned* lq_ = (volatile unsigned*)(lds + LDS_Q);
            for (;;) {
                if (C.tid == 0) lq_[0] = atomicAdd(qw, 1u);
                __syncthreads();
                const int it = (int)lq_[0];
                __syncthreads();
                if (it >= 64 + 128 + 1024 + 64) break;
                if (HAS(6) && it < 64) scan_unit(C, l, 0, it >> 4, (it >> 2) & 3, it & 3, lds);
                else if (HAS(6) && it < 192) { const int s = it - 64; scan_unit(C, l, 1, s >> 4, (s >> 2) & 3, s & 3, lds); }
                else if (HAS(7) && it < 1216) { const int a = it - 192; attn_unit(C, l, 0, (a & 31) >> 3, a & 7, 31 - (a >> 5), lds); }
                else if (HAS(7)) { const int a = it - 1216; attn_unit(C, l, 1, a >> 3, a & 7, 0, lds); }
            }
        } else if constexpr (HAS(8) && q == 6) { MKCTX; gdn_norm_phase(C, l); }
        else if constexpr (HAS(9) && q == 7) { MKCTX;
#pragma unroll 1
            for (int br = 0; br < 2; ++br) { pg8::Gemm g{C.P + (br ? 3072 : 0), Wb + (br ? W_BGD : W_BSB) / 2, M, D, 512, PIN}; pg8::StaticOrder S; S.init(M, D, C.G, C.bid); pg8::EpiPlain E{br ? Y1 : Y0, D};
              pg8::gemm_phase<pg8::EpiPlain, pg8::StaticOrder, true, true>(lds3, g, S, E); }
        } else if constexpr (HAS(10) && q == 8) { MKCTX;
            pg8::Gemm g{C.XN, Wb + W_G / 2, M, NGATE, D, D}; pg8::StaticOrder S; S.init(M, NGATE, C.G, C.bid);
            pg8::EpiGate E{Y0, Y1}; pg8::gemm_phase<pg8::EpiGate, pg8::StaticOrder, true, true>(lds3, g, S, E);
        }
}
__global__ void __launch_bounds__(512, 2) fwd(Args args) {
    extern __shared__ __attribute__((aligned(16))) unsigned char lds[];
    const int lo = args.ph_lo, hi = args.ph_hi;
#define RUN(P) if ((P) >= lo && (P) < hi) { run_phase<P>(lds); if ((P) + 1 < hi) cg::this_grid().sync(); }
    RUN(0) RUN(1) RUN(2) RUN(3) RUN(4) RUN(5) RUN(6) RUN(7) RUN(8) RUN(9) RUN(10) RUN(11) RUN(12) RUN(13) RUN(14)
    RUN(15) RUN(16) RUN(17) RUN(18) RUN(19) RUN(20) RUN(21) RUN(22) RUN(23) RUN(24) RUN(25) RUN(26) RUN(27) RUN(28)
#undef RUN
}

#ifndef MK_SINGLE
#define MK_SINGLE 1
#endif
extern "C" void kernel_launch(void* const* d_in, const int* in_sizes, int n_in, void* d_out, int out_size, void* d_ws, size_t ws_size, hipStream_t stream) {
    static int grid = 0;
    if (grid == 0) {
        if (n_in != 19 || (size_t)out_size < O_END || ws_size < WS_END) { fprintf(stderr, "kernel_launch: unexpected shapes (n_in %d, out %d, ws %zu)\n", n_in, out_size, ws_size); grid = -1; return; }
        int dev = 0, cus = 0, per_cu = 0;
        hipGetDevice(&dev); hipDeviceGetAttribute(&cus, hipDeviceAttributeMultiprocessorCount, dev);
        if (hipFuncSetAttribute((const void*)fwd, hipFuncAttributeMaxDynamicSharedMemorySize, LDS_BYTES) != hipSuccess) { fprintf(stderr, "kernel_launch: hipFuncSetAttribute failed\n"); grid = -1; return; }
        hipOccupancyMaxActiveBlocksPerMultiprocessor(&per_cu, (const void*)fwd, 512, LDS_BYTES);
        if (per_cu < 1) { fprintf(stderr, "kernel_launch: occupancy query says %d\n", per_cu); per_cu = 1; }
        (void)hipGetLastError();
        grid = cus;
    }
    if (grid < 0) return;
    hipMemsetAsync((char*)d_ws + WS_CTL, 0, CTL_BYTES, stream);
    Args a{};
    for (int i = 0; i < 19; ++i) a.in[i] = (const float*)d_in[i];
    a.out = (float*)d_out; a.ws = (unsigned char*)d_ws;
#if MK_SINGLE
    a.ph_lo = 0; a.ph_hi = NPH;
    void* kargs[] = {&a};
    hipError_t e = hipLaunchCooperativeKernel((const void*)fwd, dim3(grid), dim3(512), kargs, LDS_BYTES, stream);
    if (e != hipSuccess) fprintf(stderr, "cooperative launch failed: %s (grid %d)\n", hipGetErrorString(e), grid);
#else
    for (int ph = 0; ph < NPH; ++ph) { a.ph_lo = ph; a.ph_hi = ph + 1; hipLaunchKernelGGL(fwd, dim3(grid), dim3(512), LDS_BYTES, stream, a); }
#endif
}
```

```cpp
#include <hip/hip_runtime.h>
#include <hip/hip_cooperative_groups.h>
#include <cstdio>
#include <cstdint>
namespace cg = cooperative_groups;
namespace pg8 {
#define PG8_LAS __attribute__((address_space(3)))
typedef unsigned short bf16_t;
typedef short bf16x8 __attribute__((ext_vector_type(8)));
typedef float f32x4 __attribute__((ext_vector_type(4)));
typedef unsigned u32x4 __attribute__((ext_vector_type(4)));
constexpr int BM = 256, BK = 64, HALF = 128, HTB = HALF * BK * 2  , STAGE_BYTES = 8 * HTB, NXCD = 8, WGM = 8;

__host__ __device__ __forceinline__ int lds_byte(int r, int c) { const int st = (r >> 4) * 2 + (c >> 5), rr = r & 15, cc = c & 31, ob = rr * 64 + cc * 2; return st * 1024 + (ob ^ (((ob >> 9) & 1) << 5)); }
__host__ __device__ __forceinline__ void stage_rc(int b, int& R, int& C) { const int st = b / 1024, sb = b % 1024, swz = sb ^ (((sb >> 9) & 1) << 5); R = (st >> 1) * 16 + swz / 64; C = (st & 1) * 32 + (swz % 64) / 2; }
__host__ __device__ __forceinline__ int perm32(int rho) { const int n = rho >> 4, i = rho & 15; return 8 * (i >> 2) + 4 * n + (i & 3); }

struct Unit { int pm, pn; int koff; };
struct Gemm { const bf16_t* A; const bf16_t* Bt; int M, N, K, lda, ldb; };

struct StaticOrder {
    int nM, nN, nwg, G, c;
    __host__ __device__ void init(int M, int N, int G_, int c_) { nM = M / BM; nN = N / BM; nwg = nM * nN; G = G_; c = c_; }
    __host__ __device__ bool next(int i, Unit& u) const {
        const long L = (long)i * G + c; if (L >= nwg) return false;
        int wgid = (int)L; { const int q = nwg / NXCD, r = nwg % NXCD, xcd = wgid % NXCD, off = wgid / NXCD; wgid = (xcd < r ? xcd * (q + 1) : r * (q + 1) + (xcd - r) * q) + off; }
        const int nig = WGM * nN, gid = wgid / nig, fm = gid * WGM, gsz = (nM - fm) < WGM ? (nM - fm) : WGM;
        u.pm = fm + ((wgid % nig) % gsz); u.pn = (wgid % nig) / gsz; u.koff = 0; return true;
    }
    __device__ __forceinline__ void a_ready(const Unit&) const {}
    __device__ __forceinline__ void done(const Unit&) const {}
};


__device__ __forceinline__ unsigned cvt_pk_bf16(float lo, float hi) { typedef float f2_ __attribute__((ext_vector_type(2))); typedef __bf16 b2_ __attribute__((ext_vector_type(2))); f2_ v = {lo, hi}; b2_ b = __builtin_convertvector(v, b2_); return __builtin_bit_cast(unsigned, b); }
__device__ __forceinline__ float bflo(unsigned u) { return __uint_as_float(u << 16); }
__device__ __forceinline__ float bfhi(unsigned u) { return __uint_as_float(u & 0xffff0000u); }
__device__ __forceinline__ float sigm(float x) { return __builtin_amdgcn_rcpf(1.f + __builtin_amdgcn_exp2f(-1.4426950408889634f * x)); }
__device__ __forceinline__ u32x4 pack8(const f32x4& a, const f32x4& b) { u32x4 w; w.x = cvt_pk_bf16(a[0], a[1]); w.y = cvt_pk_bf16(a[2], a[3]); w.z = cvt_pk_bf16(b[0], b[1]); w.w = cvt_pk_bf16(b[2], b[3]); return w; }

struct EpiPlain {
    static constexpr bool PERM = true, AFTER_DRAIN = false; bf16_t* O; int ldc;
    __device__ __forceinline__ void operator()(const f32x4 (&acc)[2][2][4][2], const Unit& u, int wr, int wc, int fr, int fq) const {
        const int row0 = u.pm * BM + wr * 64 + fr, col0 = u.pn * BM + wc * 32 + 8 * fq;
#pragma unroll
        for (int ai = 0; ai < 2; ++ai)
#pragma unroll
            for (int m = 0; m < 4; ++m) { bf16_t* rowp = O + (size_t)(row0 + ai * HALF + m * 16) * ldc + col0;
#pragma unroll
                for (int bj = 0; bj < 2; ++bj) *(u32x4*)(rowp + bj * HALF) = pack8(acc[ai][bj][m][0], acc[ai][bj][m][1]); }
    }
};
struct EpiSwiglu {
    static constexpr bool PERM = true, AFTER_DRAIN = false; bf16_t* O; int ldc; const float* rs;
    __device__ __forceinline__ void operator()(const f32x4 (&acc)[2][2][4][2], const Unit& u, int wr, int wc, int fr, int fq) const {
        const int row0 = u.pm * BM + wr * 64 + fr, col0 = u.pn * HALF + wc * 32 + 8 * fq;
#pragma unroll
        for (int ai = 0; ai < 2; ++ai)
#pragma unroll
            for (int m = 0; m < 4; ++m) { bf16_t* rowp = O + (size_t)(row0 + ai * HALF + m * 16) * ldc + col0; f32x4 r0, r1; const float rr = rs[row0 + ai * HALF + m * 16];
#pragma unroll
                for (int e = 0; e < 4; ++e) { const float g0 = acc[ai][0][m][0][e] * rr, g1 = acc[ai][0][m][1][e] * rr; r0[e] = g0 * sigm(g0) * (acc[ai][1][m][0][e] * rr); r1[e] = g1 * sigm(g1) * (acc[ai][1][m][1][e] * rr); }
                *(u32x4*)rowp = pack8(r0, r1); }
    }
};
struct EpiYss {
    static constexpr bool PERM = true, AFTER_DRAIN = false; bf16_t* O; float* rowss;
    __device__ __forceinline__ void operator()(const f32x4 (&acc)[2][2][4][2], const Unit& u, int wr, int wc, int fr, int fq) const {
        const int row0 = u.pm * BM + wr * 64 + fr, col0 = u.pn * BM + wc * 32 + 8 * fq;
#pragma unroll
        for (int ai = 0; ai < 2; ++ai)
#pragma unroll
            for (int m = 0; m < 4; ++m) { const int row = row0 + ai * HALF + m * 16; bf16_t* rowp = O + (size_t)row * 1024 + col0; float ss = 0.f;
#pragma unroll
                for (int bj = 0; bj < 2; ++bj) { const f32x4 a = acc[ai][bj][m][0], b = acc[ai][bj][m][1];
                    ss += (a[0] * a[0] + a[1] * a[1]) + (a[2] * a[2] + a[3] * a[3]) + (b[0] * b[0] + b[1] * b[1]) + (b[2] * b[2] + b[3] * b[3]);
                    *(u32x4*)(rowp + bj * HALF) = pack8(a, b); }
                ss += __shfl_xor(ss, 16); ss += __shfl_xor(ss, 32);
                if (fq == 0) rowss[(size_t)row * 16 + u.pn * 4 + wc] = ss; }
    }
};
struct EpiIn {
    static constexpr bool PERM = true, AFTER_DRAIN = false; bf16_t* P; int pitch; float* kp; float* vp; float* ks; float* vs; int mp; const float* rs;
    __device__ __forceinline__ void operator()(const f32x4 (&acc)[2][2][4][2], const Unit& u, int wr, int wc, int fr, int fq) const {
        const int row0 = u.pm * BM + wr * 64 + fr, col0 = u.pn * BM + wc * 32 + 8 * fq;
        const bool kv = (u.pn >= 2 && u.pn < 6); const bool isk = u.pn < 4;
#pragma unroll
        for (int ai = 0; ai < 2; ++ai)
#pragma unroll
            for (int m = 0; m < 4; ++m) { const int row = row0 + ai * HALF + m * 16; bf16_t* rowp = P + (size_t)row * pitch + col0; const float rr = rs[row];
#pragma unroll
                for (int bj = 0; bj < 2; ++bj) { const f32x4 v0 = acc[ai][bj][m][0] * rr, v1 = acc[ai][bj][m][1] * rr; if (col0 + bj * HALF < pitch) *(u32x4*)(rowp + bj * HALF) = pack8(v0, v1);
                    if (kv) { const int cc = col0 + bj * HALF - (isk ? 512 : 1024);
                        float* o = (row < mp) ? ((isk ? kp : vp) + (size_t)row * 512 + cc) : ((isk ? ks : vs) + (size_t)(row - mp) * 512 + cc);
                        *(f32x4*)o = v0; *(f32x4*)(o + 4) = v1; } } }
    }
};
struct EpiGate {
    static constexpr bool PERM = true, AFTER_DRAIN = false; bf16_t* T0; const bf16_t* T1; const float* rs;
    __device__ __forceinline__ void operator()(const f32x4 (&acc)[2][2][4][2], const Unit& u, int wr, int wc, int fr, int fq) const {
        const int row0 = u.pm * BM + wr * 64 + fr, col0 = u.pn * HALF + wc * 32 + 8 * fq;
#pragma unroll
        for (int ai = 0; ai < 2; ++ai)
#pragma unroll
            for (int m = 0; m < 4; ++m) { const size_t off = (size_t)(row0 + ai * HALF + m * 16) * 1024 + col0; const float rr = rs[row0 + ai * HALF + m * 16];
                const u32x4 a = *(const u32x4*)(T0 + off), b = *(const u32x4*)(T1 + off); f32x4 r0, r1;
#pragma unroll
                for (int e = 0; e < 4; ++e) { const unsigned wa0 = a[e >> 1], wb0 = b[e >> 1], wa1 = a[2 + (e >> 1)], wb1 = b[2 + (e >> 1)];
                    const float t00 = (e & 1) ? bfhi(wa0) : bflo(wa0), t10 = (e & 1) ? bfhi(wb0) : bflo(wb0), t01 = (e & 1) ? bfhi(wa1) : bflo(wa1), t11 = (e & 1) ? bfhi(wb1) : bflo(wb1);
                    r0[e] = sigm(acc[ai][0][m][0][e] * rr) * t00 + sigm(acc[ai][1][m][0][e] * rr) * t10;
                    r1[e] = sigm(acc[ai][0][m][1][e] * rr) * t01 + sigm(acc[ai][1][m][1][e] * rr) * t11; }
                *(u32x4*)(T0 + off) = pack8(r0, r1); }
    }
};


struct SplitKOrder { int nslice, G, c;
    __device__ __forceinline__ bool next(int i, Unit& u) const { const int L = i * G + c; if (L >= 8 * nslice) return false; u.pm = (L >> 2) & 1; u.pn = L & 3; u.koff = (L >> 3) * 512; return true; }
    __device__ __forceinline__ void a_ready(const Unit&) const {}
    __device__ __forceinline__ void done(const Unit&) const {}
};
struct EpiPart { static constexpr bool PERM = true, AFTER_DRAIN = false; float* part;
    __device__ __forceinline__ void operator()(const f32x4 (&acc)[2][2][4][2], const Unit& u, int wr, int wc, int fr, int fq) const {
        const int row0 = u.pm * BM + wr * 64 + fr, col0 = u.pn * BM + wc * 32 + 8 * fq; float* base = part + (size_t)(u.koff >> 9) * 512 * 1024;
#pragma unroll
        for (int ai = 0; ai < 2; ++ai)
#pragma unroll
            for (int m = 0; m < 4; ++m) { float* rowp = base + (size_t)(row0 + ai * HALF + m * 16) * 1024 + col0;
#pragma unroll
                for (int bj = 0; bj < 2; ++bj) { *(f32x4*)(rowp + bj * HALF) = acc[ai][bj][m][0]; *(f32x4*)(rowp + bj * HALF + 4) = acc[ai][bj][m][1]; }
                asm volatile("" ::: "memory"); }
    }
};
template <class Epi, class Sched, bool ALIGN_EPI = false, bool SP2 = false>
__device__ __forceinline__ void gemm_phase(PG8_LAS unsigned char* lds, const Gemm g, const Sched& S, const Epi& E, int tid_in) {
    int tid_ = tid_in; asm volatile("" : "+v"(tid_));
    const int tid = tid_, wid = __builtin_amdgcn_readfirstlane(tid >> 6), lane = tid & 63, wr = wid >> 2, wc = wid & 3, fr = lane & 15, fq = lane >> 4;
    const int K = g.K, nt = K / BK;
    unsigned voffA[2], voffB[2];
#pragma unroll
    for (int i = 0; i < 2; ++i) { int R, C; stage_rc(tid * 16 + i * 8192, R, C); const int Rb = Epi::PERM ? ((R & ~31) + perm32(R & 31)) : R;
        voffA[i] = (unsigned)(R * g.lda + C) * 2u; voffB[i] = (unsigned)(Rb * g.ldb + C) * 2u; }
    const size_t kstep = (size_t)(BK * 2);
    const size_t hstepA = (size_t)HALF * g.lda * 2, hstepB = (size_t)HALF * g.ldb * 2;
    const size_t tstepA = 2 * hstepA, tstepB = 2 * hstepB;
    const unsigned ldsw = (unsigned)wid * 1024u;
    const int aoff = lds_byte(wr * 64 + fr, fq * 8), boff = lds_byte(wc * 32 + fr, fq * 8);
#define PG8_SA(b, h) (((b) * 2 + (h)) * HTB)
#define PG8_SB(b, h) ((4 + (b) * 2 + (h)) * HTB)
#define PG8_STAGE(bufoff, gbase, voff) do { _Pragma("unroll") for (int _i = 0; _i < 2; ++_i) \
        __builtin_amdgcn_global_load_lds((const unsigned*)((const char*)(gbase) + (voff)[_i]), (PG8_LAS unsigned*)(lds + (bufoff) + ldsw + _i * 8192), 16, 0, 0); } while (0)
#define PG8_LDA(dst, b, h) do { _Pragma("unroll") for (int m = 0; m < 4; ++m) _Pragma("unroll") for (int k = 0; k < 2; ++k) dst[m][k] = *(const PG8_LAS bf16x8*)(lds + PG8_SA(b, h) + aoff + m * 2048 + k * 1024); } while (0)
#define PG8_LDB(dst, b, h) do { _Pragma("unroll") for (int n = 0; n < 2; ++n) _Pragma("unroll") for (int k = 0; k < 2; ++k) dst[n][k] = *(const PG8_LAS bf16x8*)(lds + PG8_SB(b, h) + boff + n * 2048 + k * 1024); } while (0)
#define PG8_MMA(ai, bj, At, Bt) do { __builtin_amdgcn_s_setprio(1); _Pragma("unroll") for (int m = 0; m < 4; ++m) _Pragma("unroll") for (int n = 0; n < 2; ++n) _Pragma("unroll") for (int k = 0; k < 2; ++k) \
        acc[ai][bj][m][n] = __builtin_amdgcn_mfma_f32_16x16x32_bf16(Bt[n][k], At[m][k], acc[ai][bj][m][n], 0, 0, 0); __builtin_amdgcn_s_setprio(0); } while (0)
#define PG8_WAIT_V(n) asm volatile("s_waitcnt vmcnt(" #n ")" ::: "memory")
#define PG8_WAIT_L(n) asm volatile("s_waitcnt lgkmcnt(" #n ")" ::: "memory")
#define PG8_BAR __builtin_amdgcn_s_barrier()
#define PG8_SCHED __builtin_amdgcn_sched_barrier(0)
    Unit cur, nxt; int ui = 0;
    if (!S.next(0, cur)) return;
    f32x4 acc[2][2][4][2];
#pragma unroll
    for (int a = 0; a < 2; ++a)
#pragma unroll
        for (int b = 0; b < 2; ++b)
#pragma unroll
            for (int m = 0; m < 4; ++m)
#pragma unroll
                for (int n = 0; n < 2; ++n) acc[a][b][m][n] = (f32x4){0.f, 0.f, 0.f, 0.f};
    bf16x8 At[4][2], B0[2][2], B1[2][2];
    const char* cA = (const char*)g.A + (size_t)cur.pm * tstepA + cur.koff; const char* cB = (const char*)g.Bt + (size_t)cur.pn * tstepB + cur.koff;
    S.a_ready(cur);
    if constexpr (SP2) {
        PG8_STAGE(PG8_SB(0, 0), cB, voffB); PG8_STAGE(PG8_SB(0, 1), cB + hstepB, voffB); PG8_STAGE(PG8_SA(0, 0), cA, voffA); PG8_STAGE(PG8_SA(0, 1), cA + hstepA, voffA);
        if (wr == 1) PG8_BAR;
        PG8_WAIT_V(2); PG8_BAR;
        PG8_STAGE(PG8_SB(1, 0), cB + kstep, voffB); PG8_STAGE(PG8_SA(1, 0), cA + kstep, voffA); PG8_STAGE(PG8_SB(1, 1), cB + hstepB + kstep, voffB);
        PG8_WAIT_V(6); PG8_BAR;
    } else {
        PG8_STAGE(PG8_SB(0, 0), cB, voffB); PG8_STAGE(PG8_SA(0, 0), cA, voffA); PG8_STAGE(PG8_SB(0, 1), cB + hstepB, voffB); PG8_STAGE(PG8_SA(0, 1), cA + hstepA, voffA);
        if (wr == 1) PG8_BAR;
        PG8_WAIT_V(4); PG8_BAR;
        PG8_STAGE(PG8_SB(1, 0), cB + kstep, voffB); PG8_STAGE(PG8_SA(1, 0), cA + kstep, voffA); PG8_STAGE(PG8_SB(1, 1), cB + hstepB + kstep, voffB);
        PG8_WAIT_V(6); PG8_BAR;
    }
    for (;;) {
        const bool has_next = S.next(ui + 1, nxt);
        const char* nA = has_next ? (const char*)g.A + (size_t)nxt.pm * tstepA + nxt.koff : cA; const char* nB = has_next ? (const char*)g.Bt + (size_t)nxt.pn * tstepB + nxt.koff : cB;
        for (int t = 0; t < nt; t += 2) {
            const bool last = (t == nt - 2);
            const char* a1 = cA + (size_t)(t + 1) * kstep;
            const char* a2 = last ? nA : cA + (size_t)(t + 2) * kstep; const char* b2 = last ? nB : cB + (size_t)(t + 2) * kstep;
            const char* a3 = a2 + kstep; const char* b3 = b2 + kstep;
            if (last && has_next) S.a_ready(nxt);
            if constexpr (SP2) {
            PG8_LDB(B0, 0, 0); PG8_LDB(B1, 0, 1); PG8_SCHED; PG8_LDA(At, 0, 0); PG8_STAGE(PG8_SA(1, 1), a1 + hstepA, voffA);
            PG8_WAIT_V(8); PG8_WAIT_L(0); PG8_BAR; PG8_MMA(0, 0, At, B0); PG8_MMA(0, 1, At, B1); PG8_BAR; PG8_SCHED;
            PG8_LDA(At, 0, 1); PG8_STAGE(PG8_SB(0, 0), b2, voffB); PG8_STAGE(PG8_SB(0, 1), b2 + hstepB, voffB); PG8_STAGE(PG8_SA(0, 0), a2, voffA);
            PG8_WAIT_V(8); PG8_WAIT_L(0); PG8_BAR; PG8_MMA(1, 0, At, B0); PG8_MMA(1, 1, At, B1); PG8_BAR; PG8_SCHED;
            PG8_LDB(B0, 1, 0); PG8_LDB(B1, 1, 1); PG8_SCHED; PG8_LDA(At, 1, 0); PG8_STAGE(PG8_SA(0, 1), a2 + hstepA, voffA);
            PG8_WAIT_V(8); PG8_WAIT_L(0); PG8_BAR; PG8_MMA(0, 0, At, B0); PG8_MMA(0, 1, At, B1); PG8_BAR; PG8_SCHED;
            PG8_LDA(At, 1, 1); PG8_STAGE(PG8_SB(1, 0), b3, voffB); PG8_STAGE(PG8_SB(1, 1), b3 + hstepB, voffB); PG8_STAGE(PG8_SA(1, 0), a3, voffA);
            PG8_WAIT_V(8); PG8_WAIT_L(0); PG8_BAR; PG8_MMA(1, 0, At, B0); PG8_MMA(1, 1, At, B1); PG8_BAR; PG8_SCHED;
            } else {
            PG8_LDB(B0, 0, 0); PG8_SCHED; PG8_LDA(At, 0, 0); PG8_STAGE(PG8_SA(1, 1), a1 + hstepA, voffA);
            PG8_WAIT_L(8); PG8_BAR; PG8_WAIT_L(0); PG8_MMA(0, 0, At, B0); PG8_BAR; PG8_SCHED;
            PG8_LDB(B1, 0, 1); PG8_STAGE(PG8_SB(0, 0), b2, voffB);
            PG8_BAR; PG8_WAIT_L(0); PG8_MMA(0, 1, At, B1); PG8_BAR;
            PG8_LDA(At, 0, 1); PG8_STAGE(PG8_SA(0, 0), a2, voffA);
            PG8_BAR; PG8_WAIT_L(0); PG8_MMA(1, 0, At, B0); PG8_BAR; PG8_SCHED;
            PG8_STAGE(PG8_SB(0, 1), b2 + hstepB, voffB);
            PG8_WAIT_V(6); PG8_BAR; PG8_MMA(1, 1, At, B1); PG8_BAR;
            PG8_LDB(B0, 1, 0); PG8_SCHED; PG8_LDA(At, 1, 0); PG8_STAGE(PG8_SA(0, 1), a2 + hstepA, voffA);
            PG8_WAIT_L(8); PG8_BAR; PG8_WAIT_L(0); PG8_MMA(0, 0, At, B0); PG8_BAR; PG8_SCHED;
            PG8_LDB(B1, 1, 1); PG8_STAGE(PG8_SB(1, 0), b3, voffB);
            PG8_BAR; PG8_WAIT_L(0); PG8_MMA(0, 1, At, B1); PG8_BAR;
            PG8_LDA(At, 1, 1); PG8_STAGE(PG8_SA(1, 0), a3, voffA);
            PG8_BAR; PG8_WAIT_L(0); PG8_MMA(1, 0, At, B0); PG8_BAR; PG8_SCHED;
            PG8_STAGE(PG8_SB(1, 1), b3 + hstepB, voffB);
            PG8_WAIT_V(6); PG8_BAR; PG8_MMA(1, 1, At, B1); PG8_BAR;
            }
        }
        if constexpr (ALIGN_EPI) { if (wr == 0) PG8_BAR; }
        if constexpr (!Epi::AFTER_DRAIN) { E(acc, cur, wr, wc, fr, fq); S.done(cur); }
        if (!has_next) break;
#pragma unroll
        for (int a = 0; a < 2; ++a)
#pragma unroll
            for (int b = 0; b < 2; ++b)
#pragma unroll
                for (int m = 0; m < 4; ++m)
#pragma unroll
                    for (int n = 0; n < 2; ++n) acc[a][b][m][n] = (f32x4){0.f, 0.f, 0.f, 0.f};
        cur = nxt; cA = nA; cB = nB; ++ui;
        if constexpr (ALIGN_EPI) { if (wr == 1) PG8_BAR; }
    }
    PG8_WAIT_V(0);
    if constexpr (!ALIGN_EPI) { if (wr == 0) PG8_BAR; }
    PG8_BAR;
    if constexpr (Epi::AFTER_DRAIN) { E.fused(acc, cur, wr, wc, fr, fq, lds, wid, lane); S.done(cur); }
#undef PG8_SA
#undef PG8_SB
#undef PG8_STAGE
#undef PG8_LDA
#undef PG8_LDB
#undef PG8_MMA
#undef PG8_WAIT_V
#undef PG8_WAIT_L
#undef PG8_BAR
#undef PG8_SCHED
}
}

#define LAS __attribute__((address_space(3)))
typedef unsigned short bf16;
typedef float f32x4 __attribute__((ext_vector_type(4)));
typedef float f32x16 __attribute__((ext_vector_type(16)));
typedef short bf16x8 __attribute__((ext_vector_type(8)));
typedef short s16x4 __attribute__((ext_vector_type(4)));
typedef unsigned u32x4 __attribute__((ext_vector_type(4)));
typedef unsigned u32x2 __attribute__((ext_vector_type(2)));

constexpr int D = 1024, MP = 32768, MS = 512, M = MP + MS, FF = 2816, NUP = 5632, NINP = 3840, PIN = 3600, NGATE = 2048, SEQ = 8192, PAST = 2048, INDIM = 5640;
constexpr float EPS = 1e-6f, LOG2E = 1.4426950408889634f;
constexpr size_t MiB = 1u << 20;
constexpr size_t WS_CTL = 0, CTL_BYTES = 64 * 1024;
constexpr size_t WS_GC = 1 * MiB, WS_BE = 2 * MiB, WS_RS = 2 * MiB + 768 * 1024;
constexpr size_t WS_W = 3 * MiB;
constexpr size_t W_UP1 = 0, W_DN1 = 11534336, W_IN = 17301504, W_G = 25165824, W_BSB = 29360128, W_BGD = 30408704, W_OUT = 31457280, W_UP2 = 33554432, W_DN2 = 45088768, W_END = 50855936;
constexpr size_t WS_XN = 52 * MiB;
constexpr size_t WS_R1 = 117 * MiB;
constexpr size_t WS_YT = 346 * MiB;
constexpr size_t YT_HALF = (size_t)M * 1024 * 2;
constexpr size_t WS_OR = 476 * MiB;
constexpr size_t WS_ROWSS = 509 * MiB;
constexpr size_t WS_END = WS_ROWSS + (size_t)M * 64;
static_assert(WS_W + W_END <= WS_XN && WS_XN + (size_t)M * 1024 * 2 <= WS_R1 && WS_R1 + (size_t)M * PIN * 2 <= WS_YT && WS_YT + 2 * YT_HALF <= WS_OR && WS_OR + (size_t)M * 512 * 2 <= WS_ROWSS && WS_ROWSS + (size_t)M * 64 <= WS_END, "ws map");
constexpr size_t O_Y = 0, O_KP = (size_t)M * 1024, O_VP = O_KP + 2ull * MP * 512, O_GP = O_VP + 2ull * MP * 512, O_CP = O_GP + 2ull * 4 * 4 * 16384, O_KS = O_CP + 2ull * 4 * 3 * 1536,
                 O_VS = O_KS + 2ull * MS * 512, O_GS = O_VS + 2ull * MS * 512, O_CS = O_GS + 2ull * 8 * 4 * 16384, O_END = O_CS + 2ull * 8 * 3 * 1536;
constexpr int LDS_BYTES = 155648, LDS_Q = LDS_BYTES - 64;
constexpr int NPH = 29;

struct Args { const float* in[19]; float* out; unsigned char* ws; int ph_lo, ph_hi; };
struct Ctx {
    const float *xp, *xs, *cache_k, *cache_v, *state_gdn, *state_conv, *gains, *w1u, *w1d, *win, *convw, *alog, *dtb, *gng, *wbs, *wbg, *wout, *w2u, *w2d;
    float* out; unsigned char* ws; unsigned* ctl; float* rowss; float* gc; float* be; float* rs; bf16* XN; bf16* P; bf16* ACT; unsigned char* YT; bf16* OR;
    int tid, lane, wave, G, bid;
};
#define LDS_WAIT() asm volatile("s_waitcnt lgkmcnt(0)" ::: "memory")
__device__ __forceinline__ void lds_barrier() { asm volatile("s_waitcnt lgkmcnt(0)\n\ts_barrier" ::: "memory"); }
__device__ __forceinline__ unsigned pk2(float lo, float hi) { return pg8::cvt_pk_bf16(lo, hi); }
__device__ __forceinline__ unsigned short f2b(float x) { return (unsigned short)(pk2(x, 0.f) & 0xffffu); }
__device__ __forceinline__ float bflo(unsigned u) { return __uint_as_float(u << 16); }
__device__ __forceinline__ float bfhi(unsigned u) { return __uint_as_float(u & 0xffff0000u); }
__device__ __forceinline__ float b2f(unsigned short u) { return __uint_as_float((unsigned)u << 16); }
__device__ __forceinline__ float sigm(float x) { return pg8::sigm(x); }
__device__ __forceinline__ float wave_sum(float v) {
#pragma unroll
    for (int o = 1; o < 64; o <<= 1) v += __shfl_xor(v, o);
    return v;
}
__device__ __forceinline__ f32x4 mfma16(bf16x8 a, bf16x8 b, f32x4 c) { return __builtin_amdgcn_mfma_f32_16x16x32_bf16(a, b, c, 0, 0, 0); }
__device__ __forceinline__ f32x16 mfma32(bf16x8 a, bf16x8 b, f32x16 c) { return __builtin_amdgcn_mfma_f32_32x32x16_bf16(a, b, c, 0, 0, 0); }

#define XB_TMO      128
#define XB_XCNT(j)  (256  + 64 * (j))
#define XB_XSUB(j)  (1280 + 64 * (j))
#define XB_XGEN(j)  (2304 + 64 * (j))
#define XB_TOP      3328
#define XB_TOPGEN   3392
#define XCD_BAR_WORDS 3456
#define XB_SPIN_CAP (1u << 18)

__device__ __forceinline__ unsigned xb_ld(unsigned* p)              { return __hip_atomic_load(p, __ATOMIC_RELAXED, __HIP_MEMORY_SCOPE_AGENT); }
__device__ __forceinline__ unsigned xb_add(unsigned* p, unsigned v) { return __hip_atomic_fetch_add(p, v, __ATOMIC_RELAXED, __HIP_MEMORY_SCOPE_AGENT); }
__device__ __forceinline__ unsigned xb_xcc_id() { return (unsigned)__builtin_amdgcn_s_getreg((3 << 11) | 20) & 0xFu; }
#define XB_SPIN(cond, bar) do { unsigned _sp = 0; while (cond) { __builtin_amdgcn_s_sleep(1); \
    if ((++_sp & 255u) == 0u) { if (xb_ld(&(bar)[XB_TMO])) break; if (_sp > XB_SPIN_CAP) { atomicAdd(&(bar)[XB_TMO], 1u); break; } } } } while (0)

struct XcdBarrier {
    unsigned* bar; unsigned x;
    volatile LAS unsigned* st;
};

__device__ __forceinline__ XcdBarrier xcd_barrier_post(unsigned* bar, volatile LAS unsigned* st) {
    XcdBarrier b; b.bar = bar; b.x = xb_xcc_id(); b.st = st;
    if (threadIdx.x == 0) (void)xb_add(&bar[XB_XCNT(b.x)], 1u);
    return b;
}
__device__ __forceinline__ void xcd_barrier_complete(unsigned* bar, unsigned x, unsigned& nloc, unsigned& nx) {
    const unsigned G = gridDim.x * gridDim.y * gridDim.z;
    unsigned sum, cnt, mine, sp = 0u;
    for (;;) {
        sum = 0u; cnt = 0u; mine = 0u;
#pragma unroll
        for (unsigned j = 0; j < 16; ++j) { const unsigned c = xb_ld(&bar[XB_XCNT(j)]); sum += c; cnt += (c > 0u) ? 1u : 0u; mine = (j == x) ? c : mine; }
        if (sum == G) break;
        __builtin_amdgcn_s_sleep(1);
        if ((++sp & 255u) == 0u) { if (xb_ld(&bar[XB_TMO])) break; if (sp > XB_SPIN_CAP) { atomicAdd(&bar[XB_TMO], 1u); break; } }
    }
    nloc = mine > 0u ? mine : 1u; nx = cnt > 0u ? cnt : 1u;
}

__device__ __forceinline__ void xcd_barrier(const XcdBarrier& b) {
    asm volatile("s_waitcnt vmcnt(0)" ::: "memory");
    __syncthreads();
    if (threadIdx.x == 0) {
        unsigned* bar = b.bar;
        __builtin_amdgcn_s_waitcnt(0);
        unsigned nloc = b.st[0], nx = b.st[1];
        if (nloc == 0u) { xcd_barrier_complete(bar, b.x, nloc, nx); b.st[0] = nloc; b.st[1] = nx; }
        const unsigned old = xb_add(&bar[XB_XSUB(b.x)], 1u);
        const unsigned gen = old / nloc;
        if (old + 1u == (gen + 1u) * nloc) {
            __builtin_amdgcn_fence(__ATOMIC_RELEASE, "agent");
            asm volatile("s_waitcnt vmcnt(0)" ::: "memory");
            const unsigned og = xb_add(&bar[XB_TOP], 1u);
            const unsigned tg = og / nx;
            if (og + 1u == (tg + 1u) * nx) xb_add(&bar[XB_TOPGEN], 1u);
            else XB_SPIN(xb_ld(&bar[XB_TOPGEN]) == tg, bar);
            __builtin_amdgcn_fence(__ATOMIC_ACQUIRE, "agent");
            xb_add(&bar[XB_XGEN(b.x)], 1u);
            asm volatile("s_waitcnt vmcnt(0)" ::: "memory");
        } else {
            XB_SPIN(xb_ld(&bar[XB_XGEN(b.x)]) == gen, bar);
            __builtin_amdgcn_fence(__ATOMIC_ACQUIRE, "agent");
            asm volatile("s_waitcnt vmcnt(0)" ::: "memory");
        }
    }
    __syncthreads();
}

__device__ __forceinline__ void tr_item(const float* W, int ldw, int src0, int nvalid, int K, bf16* WT, int HW, LAS float* scr, int kb, int nb, int lane, const float* gk = nullptr) {
    const int k0 = 64 * kb, n0 = 32 * nb, c4 = lane & 7, rsub = lane >> 3, nn = n0 + 4 * c4;
    const bool ok = nn < nvalid; const float* src = W + (size_t)(k0 + rsub) * ldw + src0 + nn;
    f32x4 v[8];
#pragma unroll
    for (int i = 0; i < 8; ++i) v[i] = ok ? *(const f32x4*)(src + (size_t)(8 * i) * ldw) : (f32x4){0.f, 0.f, 0.f, 0.f};
#pragma unroll
    for (int i = 0; i < 8; ++i) { const int kk = 8 * i + rsub; const float g = gk ? gk[k0 + kk] : 1.f;
#pragma unroll
        for (int e = 0; e < 4; ++e) scr[kk * 33 + 4 * c4 + e] = v[i][e] * g; }
    LDS_WAIT(); asm volatile("" ::: "memory");
    int drow0 = n0; if (HW) { const int hf = n0 / HW, j = n0 - hf * HW; drow0 = 256 * (j >> 7) + 128 * hf + (j & 127); }
    const int c = lane & 7;
#pragma unroll
    for (int j = 0; j < 4; ++j) { const int n = (lane >> 3) + 8 * j; const LAS float* s = scr + (8 * c) * 33 + n;
        u32x4 o; o.x = pk2(s[0 * 33], s[1 * 33]); o.y = pk2(s[2 * 33], s[3 * 33]); o.z = pk2(s[4 * 33], s[5 * 33]); o.w = pk2(s[6 * 33], s[7 * 33]);
        *(u32x4*)(WT + (size_t)(drow0 + n) * K + k0 + 8 * c) = o; }
    LDS_WAIT(); asm volatile("" ::: "memory");
}
__device__ __forceinline__ void convert_weights(const Ctx& C, int l, LAS unsigned char* lds) {
    LAS float* scr = (LAS float*)(lds + C.wave * 16384);
    const int gw = C.bid * 8 + C.wave, NGW = C.G * 8;
    bf16* Wb = (bf16*)(C.ws + WS_W); const float* gl = C.gains + (size_t)l * 6 * D;
    constexpr int I_UP = 16 * 176, I_DN = 44 * 32, I_IN = 16 * 120, I_G = 16 * 64, I_B = 8 * 32, I_O = 16 * 32;
    constexpr int NITEMS = 2 * I_UP + 2 * I_DN + I_IN + I_G + 2 * I_B + I_O;
    for (int it = gw; it < NITEMS; it += NGW) {
        int r = it;
        if (r < I_UP) { tr_item(C.w1u + (size_t)l * D * NUP, NUP, 0, NUP, D, Wb + W_UP1 / 2, FF, scr, r / 176, r % 176, C.lane, gl + 0 * D); continue; } r -= I_UP;
        if (r < I_UP) { tr_item(C.w2u + (size_t)l * D * NUP, NUP, 0, NUP, D, Wb + W_UP2 / 2, FF, scr, r / 176, r % 176, C.lane, gl + 4 * D); continue; } r -= I_UP;
        if (r < I_DN) { tr_item(C.w1d + (size_t)l * FF * D, D, 0, D, FF, Wb + W_DN1 / 2, 0, scr, r / 32, r % 32, C.lane); continue; } r -= I_DN;
        if (r < I_DN) { tr_item(C.w2d + (size_t)l * FF * D, D, 0, D, FF, Wb + W_DN2 / 2, 0, scr, r / 32, r % 32, C.lane); continue; } r -= I_DN;
        if (r < I_IN) { tr_item(C.win + (size_t)l * D * INDIM, INDIM, 0, 3592, D, Wb + W_IN / 2, 0, scr, r / 120, r % 120, C.lane, gl + 2 * D); continue; } r -= I_IN;
        if (r < I_G) { tr_item(C.win + (size_t)l * D * INDIM, INDIM, 3592, 2048, D, Wb + W_G / 2, 1024, scr, r / 64, r % 64, C.lane, gl + 2 * D); continue; } r -= I_G;
        if (r < I_B) { tr_item(C.wbs + (size_t)l * 512 * D, D, 0, D, 512, Wb + W_BSB / 2, 0, scr, r / 32, r % 32, C.lane); continue; } r -= I_B;
        if (r < I_B) { tr_item(C.wbg + (size_t)l * 512 * D, D, 0, D, 512, Wb + W_BGD / 2, 0, scr, r / 32, r % 32, C.lane); continue; } r -= I_B;
        tr_item(C.wout + (size_t)l * D * D, D, 0, D, D, Wb + W_OUT / 2, 0, scr, r / 32, r % 32, C.lane);
    }
}

struct InitRow { f32x4 v0, v1, v2, v3; };
__device__ __forceinline__ InitRow init_load(const Ctx& C, int r) { const float* src = ((r < MP) ? C.xp + (size_t)r * D : C.xs + (size_t)(r - MP) * D) + 4 * C.lane;
    InitRow t; t.v0 = *(const f32x4*)(src); t.v1 = *(const f32x4*)(src + 256); t.v2 = *(const f32x4*)(src + 512); t.v3 = *(const f32x4*)(src + 768); return t; }
__device__ __forceinline__ void init_finish(const Ctx& C, const InitRow& t, int r) {
    const f32x4 q = t.v0 * t.v0 + t.v1 * t.v1 + t.v2 * t.v2 + t.v3 * t.v3;
    const float rstd = 1.0f / sqrtf(wave_sum((q[0] + q[1]) + (q[2] + q[3])) * (1.f / D) + EPS);
    bf16* xn = C.XN + (size_t)r * D + 4 * C.lane; u32x2 w;
    w.x = pk2(t.v0[0], t.v0[1]); w.y = pk2(t.v0[2], t.v0[3]); *(u32x2*)(xn) = w; w.x = pk2(t.v1[0], t.v1[1]); w.y = pk2(t.v1[2], t.v1[3]); *(u32x2*)(xn + 256) = w;
    w.x = pk2(t.v2[0], t.v2[1]); w.y = pk2(t.v2[2], t.v2[3]); *(u32x2*)(xn + 512) = w; w.x = pk2(t.v3[0], t.v3[1]); w.y = pk2(t.v3[2], t.v3[3]); *(u32x2*)(xn + 768) = w;
    if (C.lane == 0) C.rs[r] = rstd;
}
__device__ __forceinline__ void row_init_phase(const Ctx& C) {
    const int gw = C.bid * 8 + C.wave, NGW = C.G * 8;
#pragma unroll 1
    for (int r0 = gw; r0 < M; r0 += 2 * NGW) { const int r1 = (r0 + NGW < M) ? r0 + NGW : r0;
        const InitRow ta = init_load(C, r0), tb = init_load(C, r1);
        init_finish(C, ta, r0); init_finish(C, tb, r1); }
}
template <int NS> __device__ __forceinline__ void thin_rows(const Ctx& C, const bf16* Y, float scale, const float* gpost, bool final_out, const float* part, int rbeg, int rend, int rstep) {
    f32x4 gp[4];
#pragma unroll
    for (int j = 0; j < 4; ++j) gp[j] = *(const f32x4*)(gpost + 4 * C.lane + 256 * j);
    for (int r = rbeg; r < rend; r += rstep) {
        bf16* xr = C.XN + (size_t)r * D; const bf16* yr = Y + (size_t)r * D;
        f32x4 yv[4]; float ss;
        if (r >= MP) {
            float q = 0.f;
#pragma unroll
            for (int j = 0; j < 4; ++j) { f32x4 pa[NS];
#pragma unroll
                for (int ks = 0; ks < NS; ++ks) pa[ks] = *(const f32x4*)(part + ((size_t)ks * 512 + (r - MP)) * 1024 + 4 * C.lane + 256 * j);
                f32x4 a = pa[0];
#pragma unroll
                for (int ks = 1; ks < NS; ++ks) a += pa[ks];
                yv[j] = a; q += (a[0] * a[0] + a[1] * a[1]) + (a[2] * a[2] + a[3] * a[3]); }
            ss = wave_sum(q);
        } else { float pv = (C.lane < 16) ? C.rowss[(size_t)r * 16 + C.lane] : 0.f;
            pv += __shfl_xor(pv, 8); pv += __shfl_xor(pv, 4); pv += __shfl_xor(pv, 2); pv += __shfl_xor(pv, 1);
            ss = __shfl(pv, 0);
#pragma unroll
            for (int j = 0; j < 4; ++j) { const u32x2 y = *(const u32x2*)(yr + 4 * C.lane + 256 * j); yv[j] = (f32x4){bflo(y.x), bfhi(y.x), bflo(y.y), bfhi(y.y)}; } }
        const float rsy = scale / sqrtf(ss * (1.f / D) + EPS);
        f32x4 v[4]; float s = 0.f;
#pragma unroll
        for (int j = 0; j < 4; ++j) { const u32x2 x = *(const u32x2*)(xr + 4 * C.lane + 256 * j);
            v[j][0] = bflo(x.x) + yv[j][0] * rsy * gp[j][0]; v[j][1] = bfhi(x.x) + yv[j][1] * rsy * gp[j][1]; v[j][2] = bflo(x.y) + yv[j][2] * rsy * gp[j][2]; v[j][3] = bfhi(x.y) + yv[j][3] * rsy * gp[j][3];
            s += (v[j][0] * v[j][0] + v[j][1] * v[j][1]) + (v[j][2] * v[j][2] + v[j][3] * v[j][3]); }
        const float rstd = 1.0f / sqrtf(wave_sum(s) * (1.f / D) + EPS);
        if (C.lane == 0) C.rs[r] = rstd;
        float* xo = C.out + O_Y + (size_t)r * D;
#pragma unroll
        for (int j = 0; j < 4; ++j) { u32x2 w; w.x = pk2(v[j][0], v[j][1]); w.y = pk2(v[j][2], v[j][3]); *(u32x2*)(xr + 4 * C.lane + 256 * j) = w;
            if (final_out) *(f32x4*)(xo + 4 * C.lane + 256 * j) = v[j]; }
    }
}
struct ThinRow { u32x2 x0, x1, x2, x3, y0, y1, y2, y3; float pv; };
__device__ __forceinline__ ThinRow thin_load(const Ctx& C, const bf16* Y, int r) { ThinRow t; const bf16* xr = C.XN + (size_t)r * D + 4 * C.lane; const bf16* yr = Y + (size_t)r * D + 4 * C.lane;
    t.pv = (C.lane < 16) ? C.rowss[(size_t)r * 16 + C.lane] : 0.f;
    t.x0 = *(const u32x2*)(xr); t.x1 = *(const u32x2*)(xr + 256); t.x2 = *(const u32x2*)(xr + 512); t.x3 = *(const u32x2*)(xr + 768);
    t.y0 = *(const u32x2*)(yr); t.y1 = *(const u32x2*)(yr + 256); t.y2 = *(const u32x2*)(yr + 512); t.y3 = *(const u32x2*)(yr + 768); return t; }
__device__ __forceinline__ void thin_finish(const Ctx& C, const ThinRow& t, int r, float scale, const f32x4& g0, const f32x4& g1, const f32x4& g2, const f32x4& g3, bool final_out) {
    float p = t.pv; p += __shfl_xor(p, 8); p += __shfl_xor(p, 4); p += __shfl_xor(p, 2); p += __shfl_xor(p, 1);
    const float rsy = scale / sqrtf(__shfl(p, 0) * (1.f / D) + EPS);
#define TH_ROW(XX, YY, GG) (f32x4){bflo(XX.x) + bflo(YY.x) * rsy * GG[0], bfhi(XX.x) + bfhi(YY.x) * rsy * GG[1], bflo(XX.y) + bflo(YY.y) * rsy * GG[2], bfhi(XX.y) + bfhi(YY.y) * rsy * GG[3]}
    const f32x4 v0 = TH_ROW(t.x0, t.y0, g0), v1 = TH_ROW(t.x1, t.y1, g1), v2 = TH_ROW(t.x2, t.y2, g2), v3 = TH_ROW(t.x3, t.y3, g3);
#undef TH_ROW
    const f32x4 q = v0 * v0 + v1 * v1 + v2 * v2 + v3 * v3;
    const float rstd = 1.0f / sqrtf(wave_sum((q[0] + q[1]) + (q[2] + q[3])) * (1.f / D) + EPS);
    bf16* xr = C.XN + (size_t)r * D + 4 * C.lane; float* xo = C.out + O_Y + (size_t)r * D + 4 * C.lane;
    if (!final_out) { if (C.lane == 0) C.rs[r] = rstd; u32x2 w;     w.x = pk2(v0[0], v0[1]); w.y = pk2(v0[2], v0[3]); *(u32x2*)(xr) = w; w.x = pk2(v1[0], v1[1]); w.y = pk2(v1[2], v1[3]); *(u32x2*)(xr + 256) = w;
      w.x = pk2(v2[0], v2[1]); w.y = pk2(v2[2], v2[3]); *(u32x2*)(xr + 512) = w; w.x = pk2(v3[0], v3[1]); w.y = pk2(v3[2], v3[3]); *(u32x2*)(xr + 768) = w; }
    if (final_out) { *(f32x4*)(xo) = v0; *(f32x4*)(xo + 256) = v1; *(f32x4*)(xo + 512) = v2; *(f32x4*)(xo + 768) = v3; }
}
__device__ __forceinline__ void thin_rows2(const Ctx& C, const bf16* Y, float scale, const float* gpost, bool final_out, int rbeg, int rend, int rstep) {
    const f32x4 g0 = *(const f32x4*)(gpost + 4 * C.lane), g1 = *(const f32x4*)(gpost + 4 * C.lane + 256), g2 = *(const f32x4*)(gpost + 4 * C.lane + 512), g3 = *(const f32x4*)(gpost + 4 * C.lane + 768);
#pragma unroll 1
    for (int r0 = rbeg; r0 < rend; r0 += 2 * rstep) {
        const int r1 = (r0 + rstep < rend) ? r0 + rstep : r0;
        const ThinRow ta = thin_load(C, Y, r0), tb = thin_load(C, Y, r1);
        asm volatile("" ::: "memory");
        thin_finish(C, ta, r0, scale, g0, g1, g2, g3, final_out); thin_finish(C, tb, r1, scale, g0, g1, g2, g3, final_out);
    }
}
template <int NS> __device__ __forceinline__ void thin_phase(const Ctx& C, const bf16* Y, float scale, const float* gpost, bool final_out) {
    thin_rows2(C, Y, scale, gpost, final_out, C.bid * 8 + C.wave, MP, C.G * 8);
    thin_rows<NS>(C, Y, scale, gpost, final_out, (const float*)C.OR, MP + C.bid * 8 + C.wave, M, C.G * 8);
}
__device__ __forceinline__ void gdn_norm_row(const Ctx& C, int r, const u32x4& ov, const u32x4& zv, const f32x4& g0, const f32x4& g1) {
    float o[8], z[8];
#pragma unroll
    for (int e = 0; e < 4; ++e) { o[2 * e] = bflo(ov[e]); o[2 * e + 1] = bfhi(ov[e]); z[2 * e] = bflo(zv[e]); z[2 * e + 1] = bfhi(zv[e]); }
    float ss = 0.f;
#pragma unroll
    for (int e = 0; e < 8; ++e) ss += o[e] * o[e];
    ss += __shfl_xor(ss, 1); ss += __shfl_xor(ss, 2); ss += __shfl_xor(ss, 4); ss += __shfl_xor(ss, 8);
    const float rstd = 1.0f / sqrtf(ss * (1.f / 128.f) + EPS);
    f32x4 r0, r1;
#pragma unroll
    for (int e = 0; e < 4; ++e) { r0[e] = o[e] * rstd * g0[e] * z[e] * sigm(z[e]); r1[e] = o[4 + e] * rstd * g1[e] * z[4 + e] * sigm(z[4 + e]); }
    *(u32x4*)(C.P + (size_t)r * PIN + 3072 + C.lane * 8) = pg8::pack8(r0, r1);
}
__device__ __forceinline__ void gdn_norm_phase(const Ctx& C, int l) {
    const int gw = C.bid * 8 + C.wave, NGW = C.G * 8;
    const float* gain = C.gng + l * 128 + (C.lane & 15) * 8;
    const f32x4 g0 = *(const f32x4*)gain, g1 = *(const f32x4*)(gain + 4);
#pragma unroll 1
    for (int r0 = gw; r0 < M; r0 += 2 * NGW) { const int r1 = (r0 + NGW < M) ? r0 + NGW : r0;
        const u32x4 oa = *(const u32x4*)(C.OR + (size_t)r0 * 512 + C.lane * 8), za = *(const u32x4*)(C.P + (size_t)r0 * PIN + 3072 + C.lane * 8);
        const u32x4 ob = *(const u32x4*)(C.OR + (size_t)r1 * 512 + C.lane * 8), zb = *(const u32x4*)(C.P + (size_t)r1 * PIN + 3072 + C.lane * 8);
        asm volatile("" ::: "memory");
        gdn_norm_row(C, r0, oa, za, g0, g1); gdn_norm_row(C, r1, ob, zb, g0, g1); }
}

constexpr int PRE_U = 0, PRE_QN = 65536, PRE_KN = 82944, PRE_AF = 100352, PRE_RN = 117760, PRE_GC = 118272, PRE_BE = 118528;
__device__ __forceinline__ void gdn_pre_unit(const Ctx& C, int l, int n, int h, unsigned char* lds) {
    int tid_ = C.tid; asm volatile("" : "+v"(tid_));
    const int tid = tid_, lane = tid & 63, wave = __builtin_amdgcn_readfirstlane(tid >> 6);
    float* U = (float*)(lds + PRE_U); bf16* QN = (bf16*)(lds + PRE_QN); bf16* KN = (bf16*)(lds + PRE_KN); float* AF = (float*)(lds + PRE_AF);
    float* RN = (float*)(lds + PRE_RN); float* GC = (float*)(lds + PRE_GC); float* BE = (float*)(lds + PRE_BE);
    const int row0 = n * 64; const bool isS = n >= 512; const int sb = n - 512;
    const bool seq_first = isS ? true : ((n & 127) == 0); const bool seq_last = isS ? true : ((n & 127) == 127);
    unsigned char* rec = C.YT + (size_t)(n * 4 + h) * 65536;
    if (tid < 384) {
        const int cgp = tid % 48, rs = tid / 48, part = cgp >> 4, c8 = (cgp & 15) * 8, cc = part * 512 + h * 128 + c8;
        float w[4][8];
#pragma unroll
        for (int i = 0; i < 4; ++i) { const f32x4 a = *(const f32x4*)(C.convw + (size_t)(l * 4 + i) * 1536 + cc), b = *(const f32x4*)(C.convw + (size_t)(l * 4 + i) * 1536 + cc + 4);
#pragma unroll
            for (int e = 0; e < 4; ++e) { w[i][e] = a[e]; w[i][4 + e] = b[e]; } }
        float win[3][8];
#pragma unroll
        for (int i = 0; i < 3; ++i) { const int rr = 8 * rs - 3 + i;
            if (rr >= 0 || !seq_first) { const u32x4 v = *(const u32x4*)(C.P + (size_t)(row0 + rr) * PIN + 1536 + cc);
#pragma unroll
                for (int e = 0; e < 4; ++e) { win[i][2 * e] = bflo(v[e]); win[i][2 * e + 1] = bfhi(v[e]); } }
            else if (isS) { const float* sc = C.state_conv + ((size_t)(l * 8 + sb) * 3 + (3 + rr)) * 1536 + cc; const f32x4 a = *(const f32x4*)sc, b = *(const f32x4*)(sc + 4);
#pragma unroll
                for (int e = 0; e < 4; ++e) { win[i][e] = a[e]; win[i][4 + e] = b[e]; } }
            else {
#pragma unroll
                for (int e = 0; e < 8; ++e) win[i][e] = 0.f; } }
#pragma unroll
        for (int rr = 0; rr < 8; ++rr) { const int r = 8 * rs + rr; const u32x4 v = *(const u32x4*)(C.P + (size_t)(row0 + r) * PIN + 1536 + cc);
            float cur[8], y[8];
#pragma unroll
            for (int e = 0; e < 4; ++e) { cur[2 * e] = bflo(v[e]); cur[2 * e + 1] = bfhi(v[e]); }
#pragma unroll
            for (int e = 0; e < 8; ++e) { const float t = win[0][e] * w[0][e] + win[1][e] * w[1][e] + win[2][e] * w[2][e] + cur[e] * w[3][e]; y[e] = t * sigm(t);
                win[0][e] = win[1][e]; win[1][e] = win[2][e]; win[2][e] = cur[e]; }
            if (part < 2) { *(f32x4*)(U + r * 256 + part * 128 + c8) = (f32x4){y[0], y[1], y[2], y[3]}; *(f32x4*)(U + r * 256 + part * 128 + c8 + 4) = (f32x4){y[4], y[5], y[6], y[7]}; }
            else { u32x4 o; o.x = pk2(y[0], y[1]); o.y = pk2(y[2], y[3]); o.z = pk2(y[4], y[5]); o.w = pk2(y[6], y[7]); *(u32x4*)(rec + 32768 + (size_t)(r * 128 + c8) * 2) = o; }
            if (seq_last && r >= 61) { float* o = C.out + (isS ? O_CS + ((size_t)(l * 8 + sb) * 3 + (r - 61)) * 1536 : O_CP + ((size_t)(l * 4 + (n >> 7)) * 3 + (r - 61)) * 1536) + cc;
                *(f32x4*)o = (f32x4){cur[0], cur[1], cur[2], cur[3]}; *(f32x4*)(o + 4) = (f32x4){cur[4], cur[5], cur[6], cur[7]}; }
        }
    } else if (wave == 7) {
        const float bl = b2f(C.P[(size_t)(row0 + lane) * PIN + 3584 + h]), al = b2f(C.P[(size_t)(row0 + lane) * PIN + 3588 + h]);
        const float beta = sigm(bl); const float xa = al + C.dtb[l * 4 + h];
        const float sp = fmaxf(xa, 0.f) + log1pf(expf(-fabsf(xa)));
        float g = -expf(C.alog[l * 4 + h]) * sp;
#pragma unroll
        for (int o = 1; o < 64; o <<= 1) { const float t = __shfl_up(g, o); if (lane >= o) g += t; }
        GC[lane] = g; BE[lane] = beta; C.gc[(size_t)(n * 4 + h) * 64 + lane] = g; C.be[(size_t)(n * 4 + h) * 64 + lane] = beta;
    }
    lds_barrier();
    { const int r = tid >> 3, sub = tid & 7, part = sub >> 2, qt = sub & 3; const float* u = U + r * 256 + part * 128 + 32 * qt; f32x4 v[8]; float ss = 0.f;
#pragma unroll
        for (int i = 0; i < 8; ++i) { v[i] = *(const f32x4*)(u + 4 * i); ss += (v[i][0] * v[i][0] + v[i][1] * v[i][1]) + (v[i][2] * v[i][2] + v[i][3] * v[i][3]); }
        ss += __shfl_xor(ss, 1); ss += __shfl_xor(ss, 2);
        float rn = 1.0f / sqrtf(ss + EPS); if (part == 0) rn *= 0.08838834764831845f;
        bf16* dl = (part ? KN : QN) + r * 136 + 32 * qt; unsigned char* dg = rec + (part ? 16384 : 0) + (size_t)(r * 128 + 32 * qt) * 2;
#pragma unroll
        for (int i = 0; i < 4; ++i) { const u32x4 o = pg8::pack8(v[2 * i] * rn, v[2 * i + 1] * rn); *(u32x4*)(dl + 8 * i) = o; *(u32x4*)(dg + 16 * i) = o; } }
    lds_barrier();
    { const int p = wave >> 2, mt = wave & 3, lc = lane & 15, lq = lane >> 4; const bf16* Ab = (p ? QN : KN) + (16 * mt + lc) * 136 + 8 * lq;
        bf16x8 af[4];
#pragma unroll
        for (int ks = 0; ks < 4; ++ks) af[ks] = *(const bf16x8*)(Ab + 32 * ks);
#pragma unroll
        for (int nt = 0; nt < 4; ++nt) { f32x4 acc = {0.f, 0.f, 0.f, 0.f};
            if (nt <= mt) {
#pragma unroll
                for (int ks = 0; ks < 4; ++ks) acc = mfma16(af[ks], *(const bf16x8*)(KN + (16 * nt + lc) * 136 + 32 * ks + 8 * lq), acc); }
            const int j = 16 * nt + lc; const float gj = GC[j];
#pragma unroll
            for (int rg = 0; rg < 4; ++rg) { const int i = 16 * mt + 4 * lq + rg; const float dec = (i >= j) ? __expf(GC[i] - gj) : 0.f;
                if (p == 0) AF[i * 68 + j] = (i > j) ? BE[i] * acc[rg] * dec : 0.f;
                else *(bf16*)(rec + 57344 + (size_t)(i * 64 + j) * 2) = f2b((i >= j) ? acc[rg] * dec : 0.f); } } }
    lds_barrier();
    { float* XF = U; float* TP = U + 5120 + wave * 272;
      const int lc = lane & 15, lq = lane >> 4;
      if (wave == 0) {
          const float* ab = AF + (16 * lq) * 68 + 16 * lq; float x[16];
#pragma unroll
          for (int i = 0; i < 16; ++i) { float sv = (i == lc) ? 1.f : 0.f;
#pragma unroll
              for (int j = 0; j < i; ++j) sv -= ab[i * 68 + j] * x[j];
              x[i] = sv; XF[(16 * lq + i) * 68 + 16 * lq + lc] = sv; asm volatile("" ::: "memory"); }
      } else {
          for (int e = tid - 64; e < 6 * 256; e += 448) { const int bk = e >> 8, w = e & 255; const int bi = (bk < 3) ? 0 : (bk < 5 ? 1 : 2), bj = (bk < 3) ? bk + 1 : (bk < 5 ? bk - 1 : 3);
              XF[(16 * bi + (w >> 4)) * 68 + 16 * bj + (w & 15)] = 0.f; } }
      lds_barrier();
#pragma unroll
      for (int lev = 1; lev < 4; ++lev) {
          if (wave < 4 - lev) { const int bi = wave + lev, bj = wave; f32x4 p = {0.f, 0.f, 0.f, 0.f};
              for (int k = bj; k < bi; ++k) {
#pragma unroll
                  for (int ks = 0; ks < 4; ++ks) p = __builtin_amdgcn_mfma_f32_16x16x4f32(AF[(16 * bi + lc) * 68 + 16 * k + 4 * ks + lq], XF[(16 * k + 4 * ks + lq) * 68 + 16 * bj + lc], p, 0, 0, 0); }
#pragma unroll
              for (int rg = 0; rg < 4; ++rg) TP[(4 * lq + rg) * 17 + lc] = p[rg];
              f32x4 x = {0.f, 0.f, 0.f, 0.f};
#pragma unroll
              for (int ks = 0; ks < 4; ++ks) x = __builtin_amdgcn_mfma_f32_16x16x4f32(XF[(16 * bi + lc) * 68 + 16 * bi + 4 * ks + lq], TP[(4 * ks + lq) * 17 + lc], x, 0, 0, 0);
#pragma unroll
              for (int rg = 0; rg < 4; ++rg) XF[(16 * bi + 4 * lq + rg) * 68 + 16 * bj + lc] = -x[rg]; }
          lds_barrier();
      }
      { const int r = tid >> 3, c8 = (tid & 7) * 8; const f32x4 a = *(const f32x4*)(XF + r * 68 + c8), b = *(const f32x4*)(XF + r * 68 + c8 + 4);
        *(u32x4*)(rec + 49152 + (size_t)(r * 64 + c8) * 2) = pg8::pack8(a, b); }
    }
    lds_barrier();
}

constexpr int SC_SET = 58880, SC_KN = 0, SC_QN = 17408, SC_TI = 34816, SC_QK = 44032, SC_VSL = 53248  , SC_GB = 58368  , SC_ST = 2 * SC_SET, SC_STSZ = 8192, SC_DT = SC_ST + 2 * SC_STSZ, SC_VN = SC_DT + 4096, SC_VS = SC_VN + 4096;
static_assert(SC_VS + 4096 <= LDS_Q, "scan LDS");
__device__ __forceinline__ void sc_load(const Ctx& C, int n, int h, int tid, int dv0, u32x4 (&pf)[8]) {
    const unsigned char* rec_ = C.YT + (size_t)(n * 4 + h) * 65536;
    pf[0] = *(const u32x4*)(rec_ + 16384 + (size_t)tid * 16); pf[1] = *(const u32x4*)(rec_ + 16384 + (size_t)(tid + 512) * 16);
    pf[2] = *(const u32x4*)(rec_ + (size_t)tid * 16); pf[3] = *(const u32x4*)(rec_ + (size_t)(tid + 512) * 16);
    pf[4] = *(const u32x4*)(rec_ + 49152 + (size_t)tid * 16); pf[5] = *(const u32x4*)(rec_ + 57344 + (size_t)tid * 16);
    { const int p = tid & 255; pf[6] = *(const u32x4*)(rec_ + 32768 + (size_t)((p >> 2) * 128 + dv0 + 8 * (p & 3)) * 2); }
    { const int q = tid & 31; pf[7] = *(const u32x4*)((q < 16 ? C.gc : C.be) + (size_t)(n * 4 + h) * 64 + (q & 15) * 4); }
}
__device__ __forceinline__ void sc_store(unsigned char* s_, int tid, const u32x4 (&pf)[8]) {
    *(u32x4*)(s_ + SC_KN + (tid >> 4) * 272 + (tid & 15) * 16) = pf[0]; *(u32x4*)(s_ + SC_KN + (32 + (tid >> 4)) * 272 + (tid & 15) * 16) = pf[1];
    *(u32x4*)(s_ + SC_QN + (tid >> 4) * 272 + (tid & 15) * 16) = pf[2]; *(u32x4*)(s_ + SC_QN + (32 + (tid >> 4)) * 272 + (tid & 15) * 16) = pf[3];
    *(u32x4*)(s_ + SC_TI + (tid >> 3) * 144 + (tid & 7) * 16) = pf[4]; *(u32x4*)(s_ + SC_QK + (tid >> 3) * 144 + (tid & 7) * 16) = pf[5];
    if (tid < 256) *(u32x4*)(s_ + SC_VSL + (tid >> 2) * 80 + (tid & 3) * 16) = pf[6];
    if (tid < 32) *(u32x4*)(s_ + SC_GB + tid * 16) = pf[7];
}
typedef short v4i16_t __attribute__((ext_vector_type(4)));
__device__ __forceinline__ s16x4 vtr(const LAS unsigned char* p) { return __builtin_bit_cast(s16x4, __builtin_amdgcn_ds_read_tr16_b64_v4i16((LAS v4i16_t*)p)); }
__device__ __forceinline__ bf16x8 tr_frag(const LAS unsigned char* img, int rowb, int krow0, int col0, int lane) {
    const int g = lane >> 4, q = (lane & 15) >> 2, p = lane & 3;
    const LAS unsigned char* a = img + (krow0 + 8 * g + q) * rowb + (col0 + 4 * p) * 2;
    const s16x4 t0 = vtr(a), t1 = vtr(a + 4 * rowb);
    return (bf16x8){t0[0], t0[1], t0[2], t0[3], t1[0], t1[1], t1[2], t1[3]};
}
__device__ __forceinline__ void sc_step(const Ctx& C, unsigned char* lds, int cur, int n, int h, int dv0, int lane, int mt, int nt, f32x4 (&S)[2]) {
    const int lc = lane & 15, lq = lane >> 4, row0 = n * 64, i = 16 * nt + lc;
    const unsigned char* set = lds + cur * SC_SET; const LAS unsigned char* l3 = (const LAS unsigned char*)lds;
    const LAS unsigned char* STc = l3 + SC_ST + cur * SC_STSZ; unsigned char* STn = lds + SC_ST + (cur ^ 1) * SC_STSZ;
    const float* GB = (const float*)(set + SC_GB); const float gi = GB[i], bi = GB[64 + i], gl = GB[63]; const u32x2 vv = *(const u32x2*)(set + SC_VSL + i * 80 + (16 * mt + 4 * lq) * 2);
    const float eg = __expf(gi), ek = __expf(gl - gi), cd = __expf(gl);
    bf16x8 sa[4]; f32x4 acc = {0.f, 0.f, 0.f, 0.f};
#pragma unroll
    for (int ks = 0; ks < 4; ++ks) { sa[ks] = tr_frag(STc, 64, 32 * ks, 16 * mt, lane);
        acc = mfma16(sa[ks], *(const bf16x8*)(set + SC_KN + (16 * nt + lc) * 272 + (32 * ks + 8 * lq) * 2), acc); }
    { const float v0 = bflo(vv.x), v1 = bfhi(vv.x), v2 = bflo(vv.y), v3 = bfhi(vv.y);
        u32x2 d; d.x = pk2(bi * (v0 - acc[0] * eg), bi * (v1 - acc[1] * eg)); d.y = pk2(bi * (v2 - acc[2] * eg), bi * (v3 - acc[3] * eg));
        *(u32x2*)(lds + SC_DT + i * 64 + (16 * mt + 4 * lq) * 2) = d; }
    lds_barrier();
    f32x4 vn = {0.f, 0.f, 0.f, 0.f};
#pragma unroll
    for (int ks = 0; ks < 2; ++ks) vn = mfma16(tr_frag(l3 + SC_DT, 64, 32 * ks, 16 * mt, lane), *(const bf16x8*)(set + SC_TI + (16 * nt + lc) * 144 + (32 * ks + 8 * lq) * 2), vn);
    { u32x2 a, b; a.x = pk2(vn[0], vn[1]); a.y = pk2(vn[2], vn[3]); b.x = pk2(vn[0] * ek, vn[1] * ek); b.y = pk2(vn[2] * ek, vn[3] * ek);
        *(u32x2*)(lds + SC_VN + i * 64 + (16 * mt + 4 * lq) * 2) = a; *(u32x2*)(lds + SC_VS + i * 64 + (16 * mt + 4 * lq) * 2) = b; }
    lds_barrier();
    { bf16x8 va[2];
#pragma unroll
        for (int ks = 0; ks < 2; ++ks) va[ks] = tr_frag(l3 + SC_VS, 64, 32 * ks, 16 * mt, lane);
#pragma unroll
        for (int t = 0; t < 2; ++t) { const int dkt = 2 * nt + t; S[t] = S[t] * cd;
#pragma unroll
            for (int ks = 0; ks < 2; ++ks) S[t] = mfma16(va[ks], tr_frag(l3 + cur * SC_SET + SC_KN, 272, 32 * ks, 16 * dkt, lane), S[t]);
            u32x2 w; w.x = pk2(S[t][0], S[t][1]); w.y = pk2(S[t][2], S[t][3]);
            *(u32x2*)(STn + (16 * dkt + lc) * 64 + (16 * mt + 4 * lq) * 2) = w; } }
    { f32x4 a1 = {0.f, 0.f, 0.f, 0.f}, a2 = {0.f, 0.f, 0.f, 0.f};
#pragma unroll
        for (int ks = 0; ks < 4; ++ks) a1 = mfma16(sa[ks], *(const bf16x8*)(set + SC_QN + (16 * nt + lc) * 272 + (32 * ks + 8 * lq) * 2), a1);
#pragma unroll
        for (int ks = 0; ks < 2; ++ks) a2 = mfma16(tr_frag(l3 + SC_VN, 64, 32 * ks, 16 * mt, lane), *(const bf16x8*)(set + SC_QK + (16 * nt + lc) * 144 + (32 * ks + 8 * lq) * 2), a2);
        u32x2 o; o.x = pk2(a1[0] * eg + a2[0], a1[1] * eg + a2[1]); o.y = pk2(a1[2] * eg + a2[2], a1[3] * eg + a2[3]);
        *(u32x2*)(C.OR + (size_t)(row0 + i) * 512 + h * 128 + dv0 + 16 * mt + 4 * lq) = o; }
}
__device__ __forceinline__ void scan_unit(const Ctx& C, int l, int isS, int b, int h, int sl, unsigned char* lds, const XcdBarrier* xb) {
    const int tid = C.tid, lane = C.lane, wave = C.wave, lc = lane & 15, lq = lane >> 4, mt = wave & 1, nt = wave >> 1;
    const int nch = isS ? 1 : 128, n0 = isS ? 512 + b : 128 * b, dv0 = 32 * sl;
    f32x4 S[2];
#pragma unroll
    for (int t = 0; t < 2; ++t) { const int dk = 16 * (2 * nt + t) + lc;
        S[t] = isS ? *(const f32x4*)(C.state_gdn + ((size_t)((l * 8 + b) * 4 + h) * 128 + dk) * 128 + dv0 + 16 * mt + 4 * lq) : (f32x4){0.f, 0.f, 0.f, 0.f};
        { u32x2 w; w.x = pk2(S[t][0], S[t][1]); w.y = pk2(S[t][2], S[t][3]); *(u32x2*)(lds + SC_ST + (16 * (2 * nt + t) + lc) * 64 + (16 * mt + 4 * lq) * 2) = w; } }
    u32x4 pfA[8], pfB[8];
    sc_load(C, n0, h, tid, dv0, pfA); sc_store(lds, tid, pfA);
    if (nch == 1) {
        lds_barrier();
        sc_step(C, lds, 0, n0, h, dv0, lane, mt, nt, S);
        lds_barrier();
    } else {
#pragma unroll 1
        for (int half = 0; half < 4; ++half) { const int cb = 32 * half, nlast = n0 + cb + 31;
            if (half) { xcd_barrier(*xb); sc_load(C, n0 + cb, h, tid, dv0, pfA); sc_store(lds, tid, pfA); }
            sc_load(C, n0 + cb + 1, h, tid, dv0, pfB);
            lds_barrier();
            for (int c = cb; c < cb + 32; c += 2) {
                sc_load(C, min(n0 + c + 2, nlast), h, tid, dv0, pfA);
                sc_step(C, lds, 0, n0 + c, h, dv0, lane, mt, nt, S);
                sc_store(lds + SC_SET, tid, pfB);
                lds_barrier();
                sc_load(C, min(n0 + c + 3, nlast), h, tid, dv0, pfB);
                sc_step(C, lds, 1, n0 + c + 1, h, dv0, lane, mt, nt, S);
                sc_store(lds, tid, pfA);
                lds_barrier();
            }
        }
    }
    float* so = C.out + (isS ? O_GS + (size_t)((l * 8 + b) * 4 + h) * 16384 : O_GP + (size_t)((l * 4 + b) * 4 + h) * 16384);
#pragma unroll
    for (int t = 0; t < 2; ++t) *(f32x4*)(so + (size_t)(16 * (2 * nt + t) + lc) * 128 + dv0 + 16 * mt + 4 * lq) = S[t];
}

constexpr int AT_K = 0, AT_V = 8192, AT_FL = 16384;
__device__ __forceinline__ int crow(int r, int hi) { return (r & 3) + 8 * (r >> 2) + 4 * hi; }
__device__ __forceinline__ void sb_block(f32x16& p, int keybase, int qp, bool mask, float& carry, int hi) {
    float G[4];
#pragma unroll
    for (int g = 0; g < 4; ++g) { float kp[4], be[4];
#pragma unroll
        for (int e = 0; e < 4; ++e) { const float z = p[4 * g + e]; const float ex = __builtin_amdgcn_exp2f(-fabsf(z) * (0.125f * LOG2E)); const float r = __builtin_amdgcn_rcpf(1.f + ex); const float er = ex * r;
            const bool pos = z >= 0.f; float bt = pos ? r : er, kv = pos ? er : r;
            if (mask) { const int key = keybase + 8 * g + 4 * hi + e; if (key >= qp) { bt = 0.f; kv = 1.f; } }
            kp[e] = kv; be[e] = bt; }
        const float s2 = kp[3], s1 = kp[3] * kp[2], s0 = s1 * kp[1]; G[g] = s0 * kp[0];
        p[4 * g + 3] = be[3]; p[4 * g + 2] = be[2] * s2; p[4 * g + 1] = be[1] * s1; p[4 * g] = be[0] * s0; }
    float run = carry;
#pragma unroll
    for (int g = 3; g >= 0; --g) { const float gp = __shfl_xor(G[g], 32); const float aft = hi ? run : run * gp;
#pragma unroll
        for (int e = 0; e < 4; ++e) p[4 * g + e] *= aft;
        run *= G[g] * gp; }
    carry = run;
}
__device__ __forceinline__ void attn_unit(const Ctx& C, int l, int isS, int b, int h, int qb, unsigned char* lds) {
    const int tid = C.tid, lane = C.lane, wid = C.wave, r32 = lane & 31, hi = lane >> 5;
    bf16* P = C.P;
    const int q_row0 = isS ? MP + 64 * b : b * SEQ + 256 * qb, qpos0 = isS ? PAST : 256 * qb, nq = isS ? 64 : 256;
    const int kv_pos0 = isS ? PAST : 0, kv_row0 = isS ? MP + 64 * b : b * SEQ;
    const float* Kc = C.cache_k + (size_t)(l * 8 + b) * PAST * 512 + h * 64; const float* Vc = C.cache_v + (size_t)(l * 8 + b) * PAST * 512 + h * 64;
    const int T_top = (qpos0 + nq - 2) >> 6; const bool wact = 32 * wid < nq; const int wtop = (qpos0 + 32 * wid + 30) >> 6;
    bf16x8 qr[4];
#pragma unroll
    for (int d0 = 0; d0 < 4; ++d0) qr[d0] = wact ? *(const bf16x8*)(P + (size_t)(q_row0 + 32 * wid + r32) * PIN + h * 64 + d0 * 16 + hi * 8) : (bf16x8){0, 0, 0, 0, 0, 0, 0, 0};
    f32x16 o[2]; o[0] = f32x16{}; o[1] = f32x16{};
    float carry = 1.f; bool wdone = false;
    u32x4 kreg, vreg;
#define AT_LOAD(t_) do { const int pos0_ = 64 * (t_); \
        if (pos0_ >= kv_pos0) { kreg = *(const u32x4*)(P + (size_t)(kv_row0 + pos0_ - kv_pos0 + lane) * PIN + 512 + h * 64 + wid * 8); \
                                vreg = *(const u32x4*)(P + (size_t)(kv_row0 + pos0_ - kv_pos0 + (tid >> 3)) * PIN + 1024 + h * 64 + (tid & 7) * 8); } \
        else { const float* kp_ = Kc + (size_t)(pos0_ + lane) * 512 + wid * 8; kreg = pg8::pack8(*(const f32x4*)kp_, *(const f32x4*)(kp_ + 4)); \
               const float* vp_ = Vc + (size_t)(pos0_ + (tid >> 3)) * 512 + (tid & 7) * 8; vreg = pg8::pack8(*(const f32x4*)vp_, *(const f32x4*)(vp_ + 4)); } } while (0)
    AT_LOAD(T_top);
    const LAS unsigned char* l3 = (const LAS unsigned char*)lds;
    const int voff = ((lane >> 4) & 1) * 32 + (lane & 3) * 8 + (4 * hi + ((lane & 15) >> 2)) * 64;
    float* fl = (float*)(lds + AT_FL);
    for (int t = T_top; t >= 0; --t) {
        *(u32x4*)(lds + AT_K + wid * 1024 + lane * 16) = kreg;
        *(u32x4*)(lds + AT_V + ((tid & 7) >> 2) * 4096 + (tid >> 3) * 64 + (tid & 3) * 16) = vreg;
        lds_barrier();
        if (t > 0) AT_LOAD(t - 1);
        if (wact && t <= wtop && !wdone) {
            f32x16 p0 = f32x16{}, p1 = f32x16{};
#pragma unroll
            for (int d0 = 0; d0 < 4; ++d0) { const bf16x8 k0 = *(const bf16x8*)(lds + AT_K + (2 * d0 + hi) * 1024 + r32 * 16), k1 = *(const bf16x8*)(lds + AT_K + (2 * d0 + hi) * 1024 + r32 * 16 + 512);
                p0 = mfma32(k0, qr[d0], p0); p1 = mfma32(k1, qr[d0], p1); }
            const int qp = qpos0 + 32 * wid + r32; const bool mask = (64 * t + 63 >= qpos0 + 32 * wid);
            sb_block(p1, 64 * t + 32, qp, mask, carry, hi);
            sb_block(p0, 64 * t, qp, mask, carry, hi);
            bf16x8 pw[4];
            { u32x4 w; w.x = pk2(p0[0], p0[1]); w.y = pk2(p0[2], p0[3]); w.z = pk2(p0[4], p0[5]); w.w = pk2(p0[6], p0[7]); pw[0] = __builtin_bit_cast(bf16x8, w);
              w.x = pk2(p0[8], p0[9]); w.y = pk2(p0[10], p0[11]); w.z = pk2(p0[12], p0[13]); w.w = pk2(p0[14], p0[15]); pw[1] = __builtin_bit_cast(bf16x8, w);
              w.x = pk2(p1[0], p1[1]); w.y = pk2(p1[2], p1[3]); w.z = pk2(p1[4], p1[5]); w.w = pk2(p1[6], p1[7]); pw[2] = __builtin_bit_cast(bf16x8, w);
              w.x = pk2(p1[8], p1[9]); w.y = pk2(p1[10], p1[11]); w.z = pk2(p1[12], p1[13]); w.w = pk2(p1[14], p1[15]); pw[3] = __builtin_bit_cast(bf16x8, w); }
#pragma unroll
            for (int d0 = 0; d0 < 2; ++d0)
#pragma unroll
                for (int s = 0; s < 4; ++s) { const s16x4 a = vtr(l3 + AT_V + d0 * 4096 + s * 1024 + voff), c2 = vtr(l3 + AT_V + d0 * 4096 + s * 1024 + 512 + voff);
                    const bf16x8 vf = (bf16x8){a[0], a[1], a[2], a[3], c2[0], c2[1], c2[2], c2[3]};
                    o[d0] = mfma32(pw[s], vf, o[d0]); }
        }
        { float cm = wact ? carry : 0.f;
#pragma unroll
          for (int of = 1; of < 64; of <<= 1) cm = fmaxf(cm, __shfl_xor(cm, of));
          wdone = cm < 1e-30f;
          if (lane == 0) fl[wid] = cm; }
        lds_barrier();
        float mx = 0.f;
#pragma unroll
        for (int w = 0; w < 8; ++w) mx = fmaxf(mx, fl[w]);
        if (mx < 1e-30f) break;
    }
#undef AT_LOAD
    if (wact) {
#pragma unroll
        for (int d0 = 0; d0 < 2; ++d0)
#pragma unroll
            for (int r = 0; r < 16; ++r) P[(size_t)(q_row0 + 32 * wid + crow(r, hi)) * PIN + h * 64 + 32 * d0 + r32] = f2b(o[d0][r]);
    }
    lds_barrier();
}

#ifndef PHMASK
#define PHMASK 0xffff
#endif
#define HAS(k) (((PHMASK) >> (k)) & 1)
#ifndef PROBE_SEL
#define PROBE_SEL 0
#endif
#define MKCTX Ctx C; C.xp = ap->in[0]; C.xs = ap->in[1]; C.cache_k = ap->in[2]; C.cache_v = ap->in[3]; C.state_gdn = ap->in[4]; C.state_conv = ap->in[5]; C.gains = ap->in[6]; C.w1u = ap->in[7]; C.w1d = ap->in[8]; C.win = ap->in[9]; C.convw = ap->in[10]; C.alog = ap->in[11]; C.dtb = ap->in[12]; C.gng = ap->in[13]; C.wbs = ap->in[14]; C.wbg = ap->in[15]; C.wout = ap->in[16]; C.w2u = ap->in[17]; C.w2d = ap->in[18]; C.out = out_; C.ws = ws_; C.ctl = (unsigned*)(ws_ + WS_CTL); C.rowss = (float*)(ws_ + WS_ROWSS); C.gc = (float*)(ws_ + WS_GC); C.be = (float*)(ws_ + WS_BE); C.rs = (float*)(ws_ + WS_RS); C.XN = (bf16*)(ws_ + WS_XN); C.P = (bf16*)(ws_ + WS_R1); C.ACT = (bf16*)(ws_ + WS_R1); C.YT = ws_ + WS_YT; C.OR = (bf16*)(ws_ + WS_OR); C.tid = tid_; C.lane = C.tid & 63; C.wave = __builtin_amdgcn_readfirstlane(C.tid >> 6); C.G = gridDim.x; C.bid = bid_; LAS unsigned char* lds3 = (LAS unsigned char*)lds; bf16* Wb = (bf16*)(ws_ + WS_W); bf16* Y0 = (bf16*)C.YT; bf16* Y1 = (bf16*)(C.YT + YT_HALF);
template <int ph> __device__ __forceinline__ unsigned long long run_phase(unsigned char* lds, const XcdBarrier& xbar, int wv) {
    unsigned long long tsel = 0ull;
    constexpr int l = (ph - 1) / 14, q = (ph - 1) % 14;
    const __attribute__((address_space(4))) Args* ap = (const __attribute__((address_space(4))) Args*)__builtin_amdgcn_kernarg_segment_ptr();
    int tid_ = wv * 64 + (int)__builtin_amdgcn_mbcnt_hi(~0u, __builtin_amdgcn_mbcnt_lo(~0u, 0u)); int bid_ = blockIdx.x;
    asm volatile("" : "+s"(ap), "+v"(tid_), "+s"(bid_));
    unsigned char* ws_ = ap->ws; float* out_ = ap->out;
    LAS unsigned char* lds3 = (LAS unsigned char*)lds;
    bf16* Wb = (bf16*)(ws_ + WS_W); bf16* Y0 = (bf16*)(ws_ + WS_YT); bf16* Y1 = (bf16*)(ws_ + WS_YT + YT_HALF);
        if constexpr (HAS(0) && ph == 0) { MKCTX; convert_weights(C, 0, lds3); row_init_phase(C); }
        else if constexpr (HAS(1) && (q == 0 || q == 11)) { MKCTX;
            pg8::Gemm g{C.XN, Wb + (q == 0 ? W_UP1 : W_UP2) / 2, M, NUP, D, D, D}; pg8::StaticOrder S; S.init(M, NUP, C.G, C.bid);
            pg8::EpiSwiglu E{C.ACT, FF, C.rs}; pg8::gemm_phase<pg8::EpiSwiglu, pg8::StaticOrder, true, true>(lds3, g, S, E, C.tid);
        } else if constexpr (HAS(2) && (q == 1 || q == 12 || q == 9)) { MKCTX;
            const bf16* A = (q == 9) ? Y0 : C.ACT; const int K = (q == 9) ? D : FF; bf16* O = (q == 9) ? Y1 : Y0; const bf16* W = Wb + (q == 1 ? W_DN1 : q == 12 ? W_DN2 : W_OUT) / 2;
            { pg8::Gemm g{A, W, MP, D, K, K, K}; pg8::StaticOrder S; S.init(MP, D, C.G, C.bid);
              pg8::EpiYss E{O, C.rowss}; pg8::gemm_phase<pg8::EpiYss, pg8::StaticOrder, true, true>(lds3, g, S, E, C.tid); }
        } else if constexpr (HAS(3) && q == 2) { MKCTX; const float* gl = C.gains + (size_t)l * 6 * D; thin_phase<FF / 256>(C, Y0, 0.5f, gl + 1 * D, false); }
        else if constexpr (HAS(3) && q == 10) { MKCTX; const float* gl = C.gains + (size_t)l * 6 * D; thin_phase<D / 256>(C, Y1, 1.0f, gl + 3 * D, false); }
        else if constexpr (HAS(3) && q == 13) { MKCTX; const float* gl = C.gains + (size_t)l * 6 * D; if (l == 0) convert_weights(C, 1, lds3); thin_phase<FF / 256>(C, Y0, 0.5f, gl + 5 * D, l == 1); }
        else if constexpr (HAS(4) && q == 3) { MKCTX;
            pg8::Gemm g{C.XN, Wb + W_IN / 2, M, NINP, D, D, D}; pg8::StaticOrder S; S.init(M, NINP, C.G, C.bid);
            pg8::EpiIn E{C.P, PIN, C.out + O_KP + (size_t)l * MP * 512, C.out + O_VP + (size_t)l * MP * 512, C.out + O_KS + (size_t)l * MS * 512, C.out + O_VS + (size_t)l * MS * 512, MP, C.rs};
            pg8::gemm_phase<pg8::EpiIn, pg8::StaticOrder, true, true>(lds3, g, S, E, C.tid);
        } else if constexpr (HAS(5) && q == 4) { MKCTX;
            for (int u = C.bid; u < 512; u += C.G) { const int cc = u >> 2; gdn_pre_unit(C, l, 128 * (cc >> 5) + (cc & 31), u & 3, lds); } }
        else if constexpr ((HAS(6) || HAS(7)) && q == 5) { MKCTX;
            unsigned* qw = C.ctl + 64 * (1 + l); volatile unsigned* lq_ = (volatile unsigned*)(lds + LDS_Q);
            if (HAS(6) && C.bid < 64) {
                const unsigned long long tq0_ = PROBE_SEL ? __builtin_amdgcn_s_memrealtime() : 0ull;
                scan_unit(C, l, 0, C.bid >> 4, (C.bid >> 2) & 3, C.bid & 3, lds, &xbar);
                if (PROBE_SEL) tsel = __builtin_amdgcn_s_memrealtime() - tq0_; }
            int stage = (HAS(6) && C.bid < 64) ? 4 : 1;
            for (;;) {
                if (stage < 4) { const int nu = (stage == 3) ? 544 : 512;
                    for (int u = C.bid - 64; u < nu; u += C.G - 64) { const int cc = u >> 2;
                        if (u < 512) gdn_pre_unit(C, l, 128 * (cc >> 5) + 32 * stage + (cc & 31), u & 3, lds); else gdn_pre_unit(C, l, 512 + ((u - 512) >> 2), u & 3, lds); } }
                if (C.tid == 0) lq_[0] = atomicAdd(qw, 1u);
                lds_barrier();
                const int it = (int)lq_[0];
                lds_barrier();
                if (it < 1024 + 64 + 128) {
                    if (HAS(7) && it < 1024) attn_unit(C, l, 0, (it & 31) >> 3, it & 7, 31 - (it >> 5), lds);
                    else if (HAS(7) && it < 1088) { const int a = it - 1024; attn_unit(C, l, 1, a >> 3, a & 7, 0, lds); }
                    else if (HAS(6)) { const int s2 = it - 1088; scan_unit(C, l, 1, s2 >> 4, (s2 >> 2) & 3, s2 & 3, lds, nullptr); }
                } else if (stage >= 4) break;
                if (stage < 4) { xcd_barrier(xbar); ++stage; }
            }
        } else if constexpr (HAS(8) && q == 6) { MKCTX; gdn_norm_phase(C, l); }
        else if constexpr (HAS(9) && q == 7) { MKCTX;
#pragma unroll 1
            for (int br = 0; br < 2; ++br) { pg8::Gemm g{C.P + (br ? 3072 : 0), Wb + (br ? W_BGD : W_BSB) / 2, M, D, 512, PIN, 512}; pg8::StaticOrder S; S.init(M, D, C.G, C.bid); pg8::EpiPlain E{br ? Y1 : Y0, D};
              pg8::gemm_phase<pg8::EpiPlain, pg8::StaticOrder, true, true>(lds3, g, S, E, C.tid); }
        } else if constexpr (HAS(10) && q == 8) { MKCTX;
            pg8::Gemm g{C.XN, Wb + W_G / 2, M, NGATE, D, D, D}; pg8::StaticOrder S; S.init(M, NGATE, C.G, C.bid);
            pg8::EpiGate E{Y0, Y1, C.rs}; pg8::gemm_phase<pg8::EpiGate, pg8::StaticOrder, true, true>(lds3, g, S, E, C.tid);
        }
    return tsel;
}
template <int ph> __device__ __forceinline__ void run_phase_b(unsigned char* lds, int wv) {
    constexpr int l = (ph - 1) / 14, q = (ph - 1) % 14;
    if constexpr (HAS(2) && ph > 0 && (q == 1 || q == 12 || q == 9)) {
        const __attribute__((address_space(4))) Args* ap = (const __attribute__((address_space(4))) Args*)__builtin_amdgcn_kernarg_segment_ptr();
        int bid_ = blockIdx.x;
        asm volatile("" : "+s"(ap), "+s"(bid_));
        unsigned char* ws_ = ap->ws;
        const bf16* A = (q == 9) ? (const bf16*)(ws_ + WS_YT) : (const bf16*)(ws_ + WS_R1); constexpr int K = (q == 9) ? D : FF;
        const bf16* W = (const bf16*)(ws_ + WS_W) + (q == 1 ? W_DN1 : q == 12 ? W_DN2 : W_OUT) / 2;
        pg8::Gemm g{A + (size_t)MP * K, W, MS, D, 256, K, K}; pg8::SplitKOrder S{K / 256, (int)gridDim.x, bid_};
        pg8::EpiPart E{(float*)(ws_ + WS_OR)}; pg8::gemm_phase<pg8::EpiPart, pg8::SplitKOrder, true, true>((LAS unsigned char*)lds, g, S, E, wv * 64 + (int)__builtin_amdgcn_mbcnt_hi(~0u, __builtin_amdgcn_mbcnt_lo(~0u, 0u)));
    }
}
__global__ void __launch_bounds__(512, 2) fwd(Args args) {
    extern __shared__ __attribute__((aligned(16))) unsigned char lds[];
    const int lo = args.ph_lo, hi = args.ph_hi;
    const int wv = __builtin_amdgcn_readfirstlane(threadIdx.x >> 6);
    volatile LAS unsigned* xst = (volatile LAS unsigned*)((LAS unsigned char*)lds + LDS_Q + 16);
    if (threadIdx.x < 2) xst[threadIdx.x] = 0u;
    __syncthreads();
    (void)xcd_barrier_post((unsigned*)args.ws + 2048, xst);
#ifndef PROBE_MASK
#define PROBE_MASK 0u
#define PROBE_AMP 4
#endif
    unsigned long long tacc = 0ull;
#define RUN(P) if ((P) >= lo && (P) < hi) { XcdBarrier xbar; xbar.bar = (unsigned*)args.ws + 2048; xbar.x = xb_xcc_id(); xbar.st = xst; unsigned long long t0_ = 0ull; if ((PROBE_MASK >> (P)) & 1u) t0_ = __builtin_amdgcn_s_memrealtime(); \
        const unsigned long long ts_ = run_phase<P>(lds, xbar, wv); run_phase_b<P>(lds, wv); if (PROBE_SEL) tacc += ts_; if ((P) + 1 < hi) { if ((P) == 0 && lo < 0) cg::this_grid().sync(); else xcd_barrier(xbar); }     if ((PROBE_MASK >> (P)) & 1u) tacc += __builtin_amdgcn_s_memrealtime() - t0_; }
    RUN(0) RUN(1) RUN(2) RUN(3) RUN(4) RUN(5) RUN(6) RUN(7) RUN(8) RUN(9) RUN(10) RUN(11) RUN(12) RUN(13) RUN(14)
    RUN(15) RUN(16) RUN(17) RUN(18) RUN(19) RUN(20) RUN(21) RUN(22) RUN(23) RUN(24) RUN(25) RUN(26) RUN(27) RUN(28)
    if ((PROBE_MASK != 0u || PROBE_SEL) && blockIdx.x == 0 && threadIdx.x == 0) { const unsigned long long t1_ = __builtin_amdgcn_s_memrealtime(); while (__builtin_amdgcn_s_memrealtime() - t1_ < (unsigned long long)PROBE_AMP * tacc) __builtin_amdgcn_s_sleep(8); }
#undef RUN
}

#ifndef MK_SINGLE
#define MK_SINGLE 1
#endif
extern "C" void kernel_launch(void* const* d_in, const int* in_sizes, int n_in, void* d_out, int out_size, void* d_ws, size_t ws_size, hipStream_t stream) {
    static int grid = 0;
    if (grid == 0) {
        if (n_in != 19 || (size_t)out_size < O_END || ws_size < WS_END) { fprintf(stderr, "kernel_launch: unexpected shapes (n_in %d, out %d, ws %zu)\n", n_in, out_size, ws_size); grid = -1; return; }
        int dev = 0, cus = 0, per_cu = 0;
        hipGetDevice(&dev); hipDeviceGetAttribute(&cus, hipDeviceAttributeMultiprocessorCount, dev);
        if (hipFuncSetAttribute((const void*)fwd, hipFuncAttributeMaxDynamicSharedMemorySize, LDS_BYTES) != hipSuccess) { fprintf(stderr, "kernel_launch: hipFuncSetAttribute failed\n"); grid = -1; return; }
        hipOccupancyMaxActiveBlocksPerMultiprocessor(&per_cu, (const void*)fwd, 512, LDS_BYTES);
        if (per_cu < 1) { fprintf(stderr, "kernel_launch: occupancy query says %d\n", per_cu); per_cu = 1; }
        (void)hipGetLastError();
        grid = cus;
    }
    if (grid < 0) return;
    hipMemsetAsync((char*)d_ws + WS_CTL, 0, CTL_BYTES, stream);
    Args a{};
    for (int i = 0; i < 19; ++i) a.in[i] = (const float*)d_in[i];
    a.out = (float*)d_out; a.ws = (unsigned char*)d_ws;
#if MK_SINGLE
    a.ph_lo = 0; a.ph_hi = NPH;
    void* kargs[] = {&a};
    hipError_t e = hipLaunchCooperativeKernel((const void*)fwd, dim3(grid), dim3(512), kargs, LDS_BYTES, stream);
    if (e != hipSuccess) fprintf(stderr, "cooperative launch failed: %s (grid %d)\n", hipGetErrorString(e), grid);
#else
    for (int ph = 0; ph < NPH; ++ph) { a.ph_lo = ph; a.ph_hi = ph + 1; hipLaunchKernelGGL(fwd, dim3(grid), dim3(512), LDS_BYTES, stream, a); }
#endif
}
```

```cpp
#include <hip/hip_runtime.h>
#include <hip/hip_cooperative_groups.h>
#include <cstdio>
#include <cstdint>
namespace cg = cooperative_groups;
namespace pg8 {
#define PG8_LAS __attribute__((address_space(3)))
typedef unsigned short bf16_t;
typedef short bf16x8 __attribute__((ext_vector_type(8)));
typedef float f32x4 __attribute__((ext_vector_type(4)));
typedef unsigned u32x4 __attribute__((ext_vector_type(4)));
constexpr int BM = 256, BK = 64, HALF = 128, HTB = HALF * BK * 2  , STAGE_BYTES = 8 * HTB, NXCD = 8, WGM = 8;

__host__ __device__ __forceinline__ int lds_byte(int r, int c) { const int st = (r >> 4) * 2 + (c >> 5), rr = r & 15, cc = c & 31, ob = rr * 64 + cc * 2; return st * 1024 + (ob ^ (((ob >> 9) & 1) << 5)); }
__host__ __device__ __forceinline__ void stage_rc(int b, int& R, int& C) { const int st = b / 1024, sb = b % 1024, swz = sb ^ (((sb >> 9) & 1) << 5); R = (st >> 1) * 16 + swz / 64; C = (st & 1) * 32 + (swz % 64) / 2; }
__host__ __device__ __forceinline__ int perm32(int rho) { const int n = rho >> 4, i = rho & 15; return 8 * (i >> 2) + 4 * n + (i & 3); }

struct Unit { int pm, pn; int koff; };
struct Gemm { const bf16_t* A; const bf16_t* Bt; int M, N, K, lda, ldb; };

struct StaticOrder {
    int nM, nN, nwg, G, c;
    __host__ __device__ void init(int M, int N, int G_, int c_) { nM = M / BM; nN = N / BM; nwg = nM * nN; G = G_; c = c_; }
    __host__ __device__ bool next(int i, Unit& u) const {
        const long L = (long)i * G + c; if (L >= nwg) return false;
        int wgid = (int)L; { const int q = nwg / NXCD, r = nwg % NXCD, xcd = wgid % NXCD, off = wgid / NXCD; wgid = (xcd < r ? xcd * (q + 1) : r * (q + 1) + (xcd - r) * q) + off; }
        const int nig = WGM * nN, gid = wgid / nig, fm = gid * WGM, gsz = (nM - fm) < WGM ? (nM - fm) : WGM;
        u.pm = fm + ((wgid % nig) % gsz); u.pn = (wgid % nig) / gsz; u.koff = 0; return true;
    }
    __device__ __forceinline__ void a_ready(const Unit&) const {}
    __device__ __forceinline__ void done(const Unit&) const {}
};


__device__ __forceinline__ unsigned cvt_pk_bf16(float lo, float hi) { typedef float f2_ __attribute__((ext_vector_type(2))); typedef __bf16 b2_ __attribute__((ext_vector_type(2))); f2_ v = {lo, hi}; b2_ b = __builtin_convertvector(v, b2_); return __builtin_bit_cast(unsigned, b); }
__device__ __forceinline__ float bflo(unsigned u) { return __uint_as_float(u << 16); }
__device__ __forceinline__ float bfhi(unsigned u) { return __uint_as_float(u & 0xffff0000u); }
__device__ __forceinline__ float sigm(float x) { return __builtin_amdgcn_rcpf(1.f + __builtin_amdgcn_exp2f(-1.4426950408889634f * x)); }
__device__ __forceinline__ u32x4 pack8(const f32x4& a, const f32x4& b) { u32x4 w; w.x = cvt_pk_bf16(a[0], a[1]); w.y = cvt_pk_bf16(a[2], a[3]); w.z = cvt_pk_bf16(b[0], b[1]); w.w = cvt_pk_bf16(b[2], b[3]); return w; }

struct EpiPlain {
    static constexpr bool PERM = true, AFTER_DRAIN = false; bf16_t* O; int ldc;
    __device__ __forceinline__ void operator()(const f32x4 (&acc)[2][2][4][2], const Unit& u, int wr, int wc, int fr, int fq) const {
        const int row0 = u.pm * BM + wr * 64 + fr, col0 = u.pn * BM + wc * 32 + 8 * fq;
#pragma unroll
        for (int ai = 0; ai < 2; ++ai)
#pragma unroll
            for (int m = 0; m < 4; ++m) { bf16_t* rowp = O + (size_t)(row0 + ai * HALF + m * 16) * ldc + col0;
#pragma unroll
                for (int bj = 0; bj < 2; ++bj) *(u32x4*)(rowp + bj * HALF) = pack8(acc[ai][bj][m][0], acc[ai][bj][m][1]); }
    }
};
struct EpiSwiglu {
    static constexpr bool PERM = true, AFTER_DRAIN = false; bf16_t* O; int ldc; const float* rs;
    __device__ __forceinline__ void operator()(const f32x4 (&acc)[2][2][4][2], const Unit& u, int wr, int wc, int fr, int fq) const {
        const int row0 = u.pm * BM + wr * 64 + fr, col0 = u.pn * HALF + wc * 32 + 8 * fq;
#pragma unroll
        for (int ai = 0; ai < 2; ++ai)
#pragma unroll
            for (int m = 0; m < 4; ++m) { bf16_t* rowp = O + (size_t)(row0 + ai * HALF + m * 16) * ldc + col0; f32x4 r0, r1; const float rr = rs[row0 + ai * HALF + m * 16];
#pragma unroll
                for (int e = 0; e < 4; ++e) { const float g0 = acc[ai][0][m][0][e] * rr, g1 = acc[ai][0][m][1][e] * rr; r0[e] = g0 * sigm(g0) * (acc[ai][1][m][0][e] * rr); r1[e] = g1 * sigm(g1) * (acc[ai][1][m][1][e] * rr); }
                *(u32x4*)rowp = pack8(r0, r1); }
    }
};
struct EpiYss {
    static constexpr bool PERM = true, AFTER_DRAIN = false; bf16_t* O; float* rowss;
    __device__ __forceinline__ void operator()(const f32x4 (&acc)[2][2][4][2], const Unit& u, int wr, int wc, int fr, int fq) const {
        const int row0 = u.pm * BM + wr * 64 + fr, col0 = u.pn * BM + wc * 32 + 8 * fq;
#pragma unroll
        for (int ai = 0; ai < 2; ++ai)
#pragma unroll
            for (int m = 0; m < 4; ++m) { const int row = row0 + ai * HALF + m * 16; bf16_t* rowp = O + (size_t)row * 1024 + col0; float ss = 0.f;
#pragma unroll
                for (int bj = 0; bj < 2; ++bj) { const f32x4 a = acc[ai][bj][m][0], b = acc[ai][bj][m][1];
                    ss += (a[0] * a[0] + a[1] * a[1]) + (a[2] * a[2] + a[3] * a[3]) + (b[0] * b[0] + b[1] * b[1]) + (b[2] * b[2] + b[3] * b[3]);
                    *(u32x4*)(rowp + bj * HALF) = pack8(a, b); }
                ss += __shfl_xor(ss, 16); ss += __shfl_xor(ss, 32);
                if (fq == 0) rowss[(size_t)row * 16 + u.pn * 4 + wc] = ss; }
    }
};
struct EpiIn {
    static constexpr bool PERM = true, AFTER_DRAIN = false; bf16_t* P; int pitch; float* kp; float* vp; float* ks; float* vs; int mp; const float* rs;
    __device__ __forceinline__ void operator()(const f32x4 (&acc)[2][2][4][2], const Unit& u, int wr, int wc, int fr, int fq) const {
        const int row0 = u.pm * BM + wr * 64 + fr, col0 = u.pn * BM + wc * 32 + 8 * fq;
        const bool kv = (u.pn >= 2 && u.pn < 6); const bool isk = u.pn < 4;
#pragma unroll
        for (int ai = 0; ai < 2; ++ai)
#pragma unroll
            for (int m = 0; m < 4; ++m) { const int row = row0 + ai * HALF + m * 16; bf16_t* rowp = P + (size_t)row * pitch + col0; const float rr = rs[row];
#pragma unroll
                for (int bj = 0; bj < 2; ++bj) { const f32x4 v0 = acc[ai][bj][m][0] * rr, v1 = acc[ai][bj][m][1] * rr; if (col0 + bj * HALF < pitch) *(u32x4*)(rowp + bj * HALF) = pack8(v0, v1);
                    if (kv) { const int cc = col0 + bj * HALF - (isk ? 512 : 1024);
                        float* o = (row < mp) ? ((isk ? kp : vp) + (size_t)row * 512 + cc) : ((isk ? ks : vs) + (size_t)(row - mp) * 512 + cc);
                        *(f32x4*)o = v0; *(f32x4*)(o + 4) = v1; } } }
    }
};
struct EpiGate {
    static constexpr bool PERM = true, AFTER_DRAIN = false; bf16_t* T0; const bf16_t* T1; const float* rs;
    __device__ __forceinline__ void operator()(const f32x4 (&acc)[2][2][4][2], const Unit& u, int wr, int wc, int fr, int fq) const {
        const int row0 = u.pm * BM + wr * 64 + fr, col0 = u.pn * HALF + wc * 32 + 8 * fq;
#pragma unroll
        for (int ai = 0; ai < 2; ++ai)
#pragma unroll
            for (int m = 0; m < 4; ++m) { const size_t off = (size_t)(row0 + ai * HALF + m * 16) * 1024 + col0; const float rr = rs[row0 + ai * HALF + m * 16];
                const u32x4 a = *(const u32x4*)(T0 + off), b = *(const u32x4*)(T1 + off); f32x4 r0, r1;
#pragma unroll
                for (int e = 0; e < 4; ++e) { const unsigned wa0 = a[e >> 1], wb0 = b[e >> 1], wa1 = a[2 + (e >> 1)], wb1 = b[2 + (e >> 1)];
                    const float t00 = (e & 1) ? bfhi(wa0) : bflo(wa0), t10 = (e & 1) ? bfhi(wb0) : bflo(wb0), t01 = (e & 1) ? bfhi(wa1) : bflo(wa1), t11 = (e & 1) ? bfhi(wb1) : bflo(wb1);
                    r0[e] = sigm(acc[ai][0][m][0][e] * rr) * t00 + sigm(acc[ai][1][m][0][e] * rr) * t10;
                    r1[e] = sigm(acc[ai][0][m][1][e] * rr) * t01 + sigm(acc[ai][1][m][1][e] * rr) * t11; }
                *(u32x4*)(T0 + off) = pack8(r0, r1); }
    }
};


struct SplitKOrder { int nslice, G, c;
    __device__ __forceinline__ bool next(int i, Unit& u) const { const int L = i * G + c; if (L >= 8 * nslice) return false; u.pm = (L >> 2) & 1; u.pn = L & 3; u.koff = (L >> 3) * 512; return true; }
    __device__ __forceinline__ void a_ready(const Unit&) const {}
    __device__ __forceinline__ void done(const Unit&) const {}
};
struct EpiPart { static constexpr bool PERM = true, AFTER_DRAIN = false; float* part;
    __device__ __forceinline__ void operator()(const f32x4 (&acc)[2][2][4][2], const Unit& u, int wr, int wc, int fr, int fq) const {
        const int row0 = u.pm * BM + wr * 64 + fr, col0 = u.pn * BM + wc * 32 + 8 * fq; float* base = part + (size_t)(u.koff >> 9) * 512 * 1024;
#pragma unroll
        for (int ai = 0; ai < 2; ++ai)
#pragma unroll
            for (int m = 0; m < 4; ++m) { float* rowp = base + (size_t)(row0 + ai * HALF + m * 16) * 1024 + col0;
#pragma unroll
                for (int bj = 0; bj < 2; ++bj) { *(f32x4*)(rowp + bj * HALF) = acc[ai][bj][m][0]; *(f32x4*)(rowp + bj * HALF + 4) = acc[ai][bj][m][1]; }
                asm volatile("" ::: "memory"); }
    }
};
template <class Epi, class Sched, bool ALIGN_EPI = false, bool SP2 = false>
__device__ __forceinline__ void gemm_phase(PG8_LAS unsigned char* lds, const Gemm g, const Sched& S, const Epi& E, int tid_in) {
    int tid_ = tid_in; asm volatile("" : "+v"(tid_));
    const int tid = tid_, wid = __builtin_amdgcn_readfirstlane(tid >> 6), lane = tid & 63, wr = wid >> 2, wc = wid & 3, fr = lane & 15, fq = lane >> 4;
    const int K = g.K, nt = K / BK;
    unsigned voffA[2], voffB[2];
#pragma unroll
    for (int i = 0; i < 2; ++i) { int R, C; stage_rc(tid * 16 + i * 8192, R, C); const int Rb = Epi::PERM ? ((R & ~31) + perm32(R & 31)) : R;
        voffA[i] = (unsigned)(R * g.lda + C) * 2u; voffB[i] = (unsigned)(Rb * g.ldb + C) * 2u; }
    const size_t kstep = (size_t)(BK * 2);
    const size_t hstepA = (size_t)HALF * g.lda * 2, hstepB = (size_t)HALF * g.ldb * 2;
    const size_t tstepA = 2 * hstepA, tstepB = 2 * hstepB;
    const unsigned ldsw = (unsigned)wid * 1024u;
    const int aoff = lds_byte(wr * 64 + fr, fq * 8), boff = lds_byte(wc * 32 + fr, fq * 8);
#define PG8_SA(b, h) (((b) * 2 + (h)) * HTB)
#define PG8_SB(b, h) ((4 + (b) * 2 + (h)) * HTB)
#define PG8_STAGE(bufoff, gbase, voff) do { _Pragma("unroll") for (int _i = 0; _i < 2; ++_i) \
        __builtin_amdgcn_global_load_lds((const unsigned*)((const char*)(gbase) + (voff)[_i]), (PG8_LAS unsigned*)(lds + (bufoff) + ldsw + _i * 8192), 16, 0, 0); } while (0)
#define PG8_LDA(dst, b, h) do { _Pragma("unroll") for (int m = 0; m < 4; ++m) _Pragma("unroll") for (int k = 0; k < 2; ++k) dst[m][k] = *(const PG8_LAS bf16x8*)(lds + PG8_SA(b, h) + aoff + m * 2048 + k * 1024); } while (0)
#define PG8_LDB(dst, b, h) do { _Pragma("unroll") for (int n = 0; n < 2; ++n) _Pragma("unroll") for (int k = 0; k < 2; ++k) dst[n][k] = *(const PG8_LAS bf16x8*)(lds + PG8_SB(b, h) + boff + n * 2048 + k * 1024); } while (0)
#define PG8_MMA(ai, bj, At, Bt) do { __builtin_amdgcn_s_setprio(1); _Pragma("unroll") for (int m = 0; m < 4; ++m) _Pragma("unroll") for (int n = 0; n < 2; ++n) _Pragma("unroll") for (int k = 0; k < 2; ++k) \
        acc[ai][bj][m][n] = __builtin_amdgcn_mfma_f32_16x16x32_bf16(Bt[n][k], At[m][k], acc[ai][bj][m][n], 0, 0, 0); __builtin_amdgcn_s_setprio(0); } while (0)
#define PG8_WAIT_V(n) asm volatile("s_waitcnt vmcnt(" #n ")" ::: "memory")
#define PG8_WAIT_L(n) asm volatile("s_waitcnt lgkmcnt(" #n ")" ::: "memory")
#define PG8_BAR __builtin_amdgcn_s_barrier()
#define PG8_SCHED __builtin_amdgcn_sched_barrier(0)
    Unit cur, nxt; int ui = 0;
    if (!S.next(0, cur)) return;
    f32x4 acc[2][2][4][2];
#pragma unroll
    for (int a = 0; a < 2; ++a)
#pragma unroll
        for (int b = 0; b < 2; ++b)
#pragma unroll
            for (int m = 0; m < 4; ++m)
#pragma unroll
                for (int n = 0; n < 2; ++n) acc[a][b][m][n] = (f32x4){0.f, 0.f, 0.f, 0.f};
    bf16x8 At[4][2], B0[2][2], B1[2][2];
    const char* cA = (const char*)g.A + (size_t)cur.pm * tstepA + cur.koff; const char* cB = (const char*)g.Bt + (size_t)cur.pn * tstepB + cur.koff;
    S.a_ready(cur);
    if constexpr (SP2) {
        PG8_STAGE(PG8_SB(0, 0), cB, voffB); PG8_STAGE(PG8_SB(0, 1), cB + hstepB, voffB); PG8_STAGE(PG8_SA(0, 0), cA, voffA); PG8_STAGE(PG8_SA(0, 1), cA + hstepA, voffA);
        if (wr == 1) PG8_BAR;
        PG8_WAIT_V(2); PG8_BAR;
        PG8_STAGE(PG8_SB(1, 0), cB + kstep, voffB); PG8_STAGE(PG8_SA(1, 0), cA + kstep, voffA); PG8_STAGE(PG8_SB(1, 1), cB + hstepB + kstep, voffB);
        PG8_WAIT_V(6); PG8_BAR;
    } else {
        PG8_STAGE(PG8_SB(0, 0), cB, voffB); PG8_STAGE(PG8_SA(0, 0), cA, voffA); PG8_STAGE(PG8_SB(0, 1), cB + hstepB, voffB); PG8_STAGE(PG8_SA(0, 1), cA + hstepA, voffA);
        if (wr == 1) PG8_BAR;
        PG8_WAIT_V(4); PG8_BAR;
        PG8_STAGE(PG8_SB(1, 0), cB + kstep, voffB); PG8_STAGE(PG8_SA(1, 0), cA + kstep, voffA); PG8_STAGE(PG8_SB(1, 1), cB + hstepB + kstep, voffB);
        PG8_WAIT_V(6); PG8_BAR;
    }
    for (;;) {
        const bool has_next = S.next(ui + 1, nxt);
        const char* nA = has_next ? (const char*)g.A + (size_t)nxt.pm * tstepA + nxt.koff : cA; const char* nB = has_next ? (const char*)g.Bt + (size_t)nxt.pn * tstepB + nxt.koff : cB;
        for (int t = 0; t < nt; t += 2) {
            const bool last = (t == nt - 2);
            const char* a1 = cA + (size_t)(t + 1) * kstep;
            const char* a2 = last ? nA : cA + (size_t)(t + 2) * kstep; const char* b2 = last ? nB : cB + (size_t)(t + 2) * kstep;
            const char* a3 = a2 + kstep; const char* b3 = b2 + kstep;
            if (last && has_next) S.a_ready(nxt);
            if constexpr (SP2) {
            PG8_LDB(B0, 0, 0); PG8_LDB(B1, 0, 1); PG8_SCHED; PG8_LDA(At, 0, 0); PG8_STAGE(PG8_SA(1, 1), a1 + hstepA, voffA);
            PG8_WAIT_V(8); PG8_WAIT_L(0); PG8_BAR; PG8_MMA(0, 0, At, B0); PG8_MMA(0, 1, At, B1); PG8_BAR; PG8_SCHED;
            PG8_LDA(At, 0, 1); PG8_STAGE(PG8_SB(0, 0), b2, voffB); PG8_STAGE(PG8_SB(0, 1), b2 + hstepB, voffB); PG8_STAGE(PG8_SA(0, 0), a2, voffA);
            PG8_WAIT_V(8); PG8_WAIT_L(0); PG8_BAR; PG8_MMA(1, 0, At, B0); PG8_MMA(1, 1, At, B1); PG8_BAR; PG8_SCHED;
            PG8_LDB(B0, 1, 0); PG8_LDB(B1, 1, 1); PG8_SCHED; PG8_LDA(At, 1, 0); PG8_STAGE(PG8_SA(0, 1), a2 + hstepA, voffA);
            PG8_WAIT_V(8); PG8_WAIT_L(0); PG8_BAR; PG8_MMA(0, 0, At, B0); PG8_MMA(0, 1, At, B1); PG8_BAR; PG8_SCHED;
            PG8_LDA(At, 1, 1); PG8_STAGE(PG8_SB(1, 0), b3, voffB); PG8_STAGE(PG8_SB(1, 1), b3 + hstepB, voffB); PG8_STAGE(PG8_SA(1, 0), a3, voffA);
            PG8_WAIT_V(8); PG8_WAIT_L(0); PG8_BAR; PG8_MMA(1, 0, At, B0); PG8_MMA(1, 1, At, B1); PG8_BAR; PG8_SCHED;
            } else {
            PG8_LDB(B0, 0, 0); PG8_SCHED; PG8_LDA(At, 0, 0); PG8_STAGE(PG8_SA(1, 1), a1 + hstepA, voffA);
            PG8_WAIT_L(8); PG8_BAR; PG8_WAIT_L(0); PG8_MMA(0, 0, At, B0); PG8_BAR; PG8_SCHED;
            PG8_LDB(B1, 0, 1); PG8_STAGE(PG8_SB(0, 0), b2, voffB);
            PG8_BAR; PG8_WAIT_L(0); PG8_MMA(0, 1, At, B1); PG8_BAR;
            PG8_LDA(At, 0, 1); PG8_STAGE(PG8_SA(0, 0), a2, voffA);
            PG8_BAR; PG8_WAIT_L(0); PG8_MMA(1, 0, At, B0); PG8_BAR; PG8_SCHED;
            PG8_STAGE(PG8_SB(0, 1), b2 + hstepB, voffB);
            PG8_WAIT_V(6); PG8_BAR; PG8_MMA(1, 1, At, B1); PG8_BAR;
            PG8_LDB(B0, 1, 0); PG8_SCHED; PG8_LDA(At, 1, 0); PG8_STAGE(PG8_SA(0, 1), a2 + hstepA, voffA);
            PG8_WAIT_L(8); PG8_BAR; PG8_WAIT_L(0); PG8_MMA(0, 0, At, B0); PG8_BAR; PG8_SCHED;
            PG8_LDB(B1, 1, 1); PG8_STAGE(PG8_SB(1, 0), b3, voffB);
            PG8_BAR; PG8_WAIT_L(0); PG8_MMA(0, 1, At, B1); PG8_BAR;
            PG8_LDA(At, 1, 1); PG8_STAGE(PG8_SA(1, 0), a3, voffA);
            PG8_BAR; PG8_WAIT_L(0); PG8_MMA(1, 0, At, B0); PG8_BAR; PG8_SCHED;
            PG8_STAGE(PG8_SB(1, 1), b3 + hstepB, voffB);
            PG8_WAIT_V(6); PG8_BAR; PG8_MMA(1, 1, At, B1); PG8_BAR;
            }
        }
        if constexpr (ALIGN_EPI) { if (wr == 0) PG8_BAR; }
        if constexpr (!Epi::AFTER_DRAIN) { E(acc, cur, wr, wc, fr, fq); S.done(cur); }
        if (!has_next) break;
#pragma unroll
        for (int a = 0; a < 2; ++a)
#pragma unroll
            for (int b = 0; b < 2; ++b)
#pragma unroll
                for (int m = 0; m < 4; ++m)
#pragma unroll
                    for (int n = 0; n < 2; ++n) acc[a][b][m][n] = (f32x4){0.f, 0.f, 0.f, 0.f};
        cur = nxt; cA = nA; cB = nB; ++ui;
        if constexpr (ALIGN_EPI) { if (wr == 1) PG8_BAR; }
    }
    PG8_WAIT_V(0);
    if constexpr (!ALIGN_EPI) { if (wr == 0) PG8_BAR; }
    PG8_BAR;
    if constexpr (Epi::AFTER_DRAIN) { E.fused(acc, cur, wr, wc, fr, fq, lds, wid, lane); S.done(cur); }
#undef PG8_SA
#undef PG8_SB
#undef PG8_STAGE
#undef PG8_LDA
#undef PG8_LDB
#undef PG8_MMA
#undef PG8_WAIT_V
#undef PG8_WAIT_L
#undef PG8_BAR
#undef PG8_SCHED
}
}

#define LAS __attribute__((address_space(3)))
typedef unsigned short bf16;
typedef float f32x4 __attribute__((ext_vector_type(4)));
typedef float f32x16 __attribute__((ext_vector_type(16)));
typedef short bf16x8 __attribute__((ext_vector_type(8)));
typedef short s16x4 __attribute__((ext_vector_type(4)));
typedef unsigned u32x4 __attribute__((ext_vector_type(4)));
typedef unsigned u32x2 __attribute__((ext_vector_type(2)));

constexpr int D = 1024, MP = 32768, MS = 512, M = MP + MS, FF = 2816, NUP = 5632, NINP = 3840, PIN = 3600, NGATE = 2048, SEQ = 8192, PAST = 2048, INDIM = 5640;
constexpr float EPS = 1e-6f, LOG2E = 1.4426950408889634f;
constexpr size_t MiB = 1u << 20;
constexpr size_t WS_CTL = 0, CTL_BYTES = 64 * 1024;
constexpr size_t WS_GC = 1 * MiB, WS_BE = 2 * MiB, WS_RS = 2 * MiB + 768 * 1024;
constexpr size_t WS_W = 3 * MiB;
constexpr size_t W_UP1 = 0, W_DN1 = 11534336, W_IN = 17301504, W_G = 25165824, W_BSB = 29360128, W_BGD = 30408704, W_OUT = 31457280, W_UP2 = 33554432, W_DN2 = 45088768, W_END = 50855936;
constexpr size_t WS_XN = 52 * MiB;
constexpr size_t WS_R1 = 117 * MiB;
constexpr size_t WS_YT = 346 * MiB;
constexpr size_t YT_HALF = (size_t)M * 1024 * 2;
constexpr size_t WS_OR = 476 * MiB;
constexpr size_t WS_ROWSS = 509 * MiB;
constexpr size_t WS_END = WS_ROWSS + (size_t)M * 64;
static_assert(WS_W + W_END <= WS_XN && WS_XN + (size_t)M * 1024 * 2 <= WS_R1 && WS_R1 + (size_t)M * PIN * 2 <= WS_YT && WS_YT + 2 * YT_HALF <= WS_OR && WS_OR + (size_t)M * 512 * 2 <= WS_ROWSS && WS_ROWSS + (size_t)M * 64 <= WS_END, "ws map");
constexpr size_t O_Y = 0, O_KP = (size_t)M * 1024, O_VP = O_KP + 2ull * MP * 512, O_GP = O_VP + 2ull * MP * 512, O_CP = O_GP + 2ull * 4 * 4 * 16384, O_KS = O_CP + 2ull * 4 * 3 * 1536,
                 O_VS = O_KS + 2ull * MS * 512, O_GS = O_VS + 2ull * MS * 512, O_CS = O_GS + 2ull * 8 * 4 * 16384, O_END = O_CS + 2ull * 8 * 3 * 1536;
constexpr int LDS_BYTES = 155648, LDS_Q = LDS_BYTES - 64;
constexpr int NPH = 29;

struct Args { const float* in[19]; float* out; unsigned char* ws; int ph_lo, ph_hi; };
struct Ctx {
    const float *xp, *xs, *cache_k, *cache_v, *state_gdn, *state_conv, *gains, *w1u, *w1d, *win, *convw, *alog, *dtb, *gng, *wbs, *wbg, *wout, *w2u, *w2d;
    float* out; unsigned char* ws; unsigned* ctl; float* rowss; float* gc; float* be; float* rs; bf16* XN; bf16* P; bf16* ACT; unsigned char* YT; bf16* OR;
    int tid, lane, wave, G, bid;
};
#define LDS_WAIT() asm volatile("s_waitcnt lgkmcnt(0)" ::: "memory")
__device__ __forceinline__ void lds_barrier() { asm volatile("s_waitcnt lgkmcnt(0)\n\ts_barrier" ::: "memory"); }
__device__ __forceinline__ unsigned pk2(float lo, float hi) { return pg8::cvt_pk_bf16(lo, hi); }
__device__ __forceinline__ unsigned short f2b(float x) { return (unsigned short)(pk2(x, 0.f) & 0xffffu); }
__device__ __forceinline__ float bflo(unsigned u) { return __uint_as_float(u << 16); }
__device__ __forceinline__ float bfhi(unsigned u) { return __uint_as_float(u & 0xffff0000u); }
__device__ __forceinline__ float b2f(unsigned short u) { return __uint_as_float((unsigned)u << 16); }
__device__ __forceinline__ float sigm(float x) { return pg8::sigm(x); }
__device__ __forceinline__ float wave_sum(float v) {
#pragma unroll
    for (int o = 1; o < 64; o <<= 1) v += __shfl_xor(v, o);
    return v;
}
__device__ __forceinline__ f32x4 mfma16(bf16x8 a, bf16x8 b, f32x4 c) { return __builtin_amdgcn_mfma_f32_16x16x32_bf16(a, b, c, 0, 0, 0); }
__device__ __forceinline__ f32x16 mfma32(bf16x8 a, bf16x8 b, f32x16 c) { return __builtin_amdgcn_mfma_f32_32x32x16_bf16(a, b, c, 0, 0, 0); }

#define XB_TMO      128
#define XB_XCNT(j)  (256  + 64 * (j))
#define XB_XSUB(j)  (1280 + 64 * (j))
#define XB_XGEN(j)  (2304 + 64 * (j))
#define XB_TOP      3328
#define XB_TOPGEN   3392
#define XCD_BAR_WORDS 3456
#define XB_SPIN_CAP (1u << 18)

__device__ __forceinline__ unsigned xb_ld(unsigned* p)              { return __hip_atomic_load(p, __ATOMIC_RELAXED, __HIP_MEMORY_SCOPE_AGENT); }
__device__ __forceinline__ unsigned xb_add(unsigned* p, unsigned v) { return __hip_atomic_fetch_add(p, v, __ATOMIC_RELAXED, __HIP_MEMORY_SCOPE_AGENT); }
__device__ __forceinline__ unsigned xb_xcc_id() { return (unsigned)__builtin_amdgcn_s_getreg((3 << 11) | 20) & 0xFu; }
#define XB_SPIN(cond, bar) do { unsigned _sp = 0; while (cond) { __builtin_amdgcn_s_sleep(1); \
    if ((++_sp & 255u) == 0u) { if (xb_ld(&(bar)[XB_TMO])) break; if (_sp > XB_SPIN_CAP) { atomicAdd(&(bar)[XB_TMO], 1u); break; } } } } while (0)

struct XcdBarrier {
    unsigned* bar; unsigned x;
    volatile LAS unsigned* st;
};

__device__ __forceinline__ XcdBarrier xcd_barrier_post(unsigned* bar, volatile LAS unsigned* st) {
    XcdBarrier b; b.bar = bar; b.x = xb_xcc_id(); b.st = st;
    if (threadIdx.x == 0) (void)xb_add(&bar[XB_XCNT(b.x)], 1u);
    return b;
}
__device__ __forceinline__ void xcd_barrier_complete(unsigned* bar, unsigned x, unsigned& nloc, unsigned& nx) {
    const unsigned G = gridDim.x * gridDim.y * gridDim.z;
    unsigned sum, cnt, mine, sp = 0u;
    for (;;) {
        sum = 0u; cnt = 0u; mine = 0u;
#pragma unroll
        for (unsigned j = 0; j < 16; ++j) { const unsigned c = xb_ld(&bar[XB_XCNT(j)]); sum += c; cnt += (c > 0u) ? 1u : 0u; mine = (j == x) ? c : mine; }
        if (sum == G) break;
        __builtin_amdgcn_s_sleep(1);
        if ((++sp & 255u) == 0u) { if (xb_ld(&bar[XB_TMO])) break; if (sp > XB_SPIN_CAP) { atomicAdd(&bar[XB_TMO], 1u); break; } }
    }
    nloc = mine > 0u ? mine : 1u; nx = cnt > 0u ? cnt : 1u;
}

__device__ __forceinline__ void xcd_barrier(const XcdBarrier& b) {
    asm volatile("s_waitcnt vmcnt(0)" ::: "memory");
    __syncthreads();
    if (threadIdx.x == 0) {
        unsigned* bar = b.bar;
        __builtin_amdgcn_s_waitcnt(0);
        unsigned nloc = b.st[0], nx = b.st[1];
        if (nloc == 0u) { xcd_barrier_complete(bar, b.x, nloc, nx); b.st[0] = nloc; b.st[1] = nx; }
        const unsigned old = xb_add(&bar[XB_XSUB(b.x)], 1u);
        const unsigned gen = old / nloc;
        if (old + 1u == (gen + 1u) * nloc) {
            __builtin_amdgcn_fence(__ATOMIC_RELEASE, "agent");
            asm volatile("s_waitcnt vmcnt(0)" ::: "memory");
            const unsigned og = xb_add(&bar[XB_TOP], 1u);
            const unsigned tg = og / nx;
            if (og + 1u == (tg + 1u) * nx) xb_add(&bar[XB_TOPGEN], 1u);
            else XB_SPIN(xb_ld(&bar[XB_TOPGEN]) == tg, bar);
            __builtin_amdgcn_fence(__ATOMIC_ACQUIRE, "agent");
            xb_add(&bar[XB_XGEN(b.x)], 1u);
            asm volatile("s_waitcnt vmcnt(0)" ::: "memory");
        } else {
            XB_SPIN(xb_ld(&bar[XB_XGEN(b.x)]) == gen, bar);
            __builtin_amdgcn_fence(__ATOMIC_ACQUIRE, "agent");
            asm volatile("s_waitcnt vmcnt(0)" ::: "memory");
        }
    }
    __syncthreads();
}

__device__ __forceinline__ void tr_item(const float* W, int ldw, int src0, int nvalid, int K, bf16* WT, int HW, LAS float* scr, int kb, int nb, int lane, const float* gk = nullptr) {
    const int k0 = 64 * kb, n0 = 32 * nb, c4 = lane & 7, rsub = lane >> 3, nn = n0 + 4 * c4;
    const bool ok = nn < nvalid; const float* src = W + (size_t)(k0 + rsub) * ldw + src0 + nn;
    f32x4 v[8];
#pragma unroll
    for (int i = 0; i < 8; ++i) v[i] = ok ? *(const f32x4*)(src + (size_t)(8 * i) * ldw) : (f32x4){0.f, 0.f, 0.f, 0.f};
#pragma unroll
    for (int i = 0; i < 8; ++i) { const int kk = 8 * i + rsub; const float g = gk ? gk[k0 + kk] : 1.f;
#pragma unroll
        for (int e = 0; e < 4; ++e) scr[kk * 33 + 4 * c4 + e] = v[i][e] * g; }
    LDS_WAIT(); asm volatile("" ::: "memory");
    int drow0 = n0; if (HW) { const int hf = n0 / HW, j = n0 - hf * HW; drow0 = 256 * (j >> 7) + 128 * hf + (j & 127); }
    const int c = lane & 7;
#pragma unroll
    for (int j = 0; j < 4; ++j) { const int n = (lane >> 3) + 8 * j; const LAS float* s = scr + (8 * c) * 33 + n;
        u32x4 o; o.x = pk2(s[0 * 33], s[1 * 33]); o.y = pk2(s[2 * 33], s[3 * 33]); o.z = pk2(s[4 * 33], s[5 * 33]); o.w = pk2(s[6 * 33], s[7 * 33]);
        *(u32x4*)(WT + (size_t)(drow0 + n) * K + k0 + 8 * c) = o; }
    LDS_WAIT(); asm volatile("" ::: "memory");
}
__device__ __forceinline__ void convert_weights(const Ctx& C, int l, LAS unsigned char* lds) {
    LAS float* scr = (LAS float*)(lds + C.wave * 16384);
    const int gw = C.bid * 8 + C.wave, NGW = C.G * 8;
    bf16* Wb = (bf16*)(C.ws + WS_W); const float* gl = C.gains + (size_t)l * 6 * D;
    constexpr int I_UP = 16 * 176, I_DN = 44 * 32, I_IN = 16 * 120, I_G = 16 * 64, I_B = 8 * 32, I_O = 16 * 32;
    constexpr int NITEMS = 2 * I_UP + 2 * I_DN + I_IN + I_G + 2 * I_B + I_O;
    for (int it = gw; it < NITEMS; it += NGW) {
        int r = it;
        if (r < I_UP) { tr_item(C.w1u + (size_t)l * D * NUP, NUP, 0, NUP, D, Wb + W_UP1 / 2, FF, scr, r / 176, r % 176, C.lane, gl + 0 * D); continue; } r -= I_UP;
        if (r < I_UP) { tr_item(C.w2u + (size_t)l * D * NUP, NUP, 0, NUP, D, Wb + W_UP2 / 2, FF, scr, r / 176, r % 176, C.lane, gl + 4 * D); continue; } r -= I_UP;
        if (r < I_DN) { tr_item(C.w1d + (size_t)l * FF * D, D, 0, D, FF, Wb + W_DN1 / 2, 0, scr, r / 32, r % 32, C.lane); continue; } r -= I_DN;
        if (r < I_DN) { tr_item(C.w2d + (size_t)l * FF * D, D, 0, D, FF, Wb + W_DN2 / 2, 0, scr, r / 32, r % 32, C.lane); continue; } r -= I_DN;
        if (r < I_IN) { tr_item(C.win + (size_t)l * D * INDIM, INDIM, 0, 3592, D, Wb + W_IN / 2, 0, scr, r / 120, r % 120, C.lane, gl + 2 * D); continue; } r -= I_IN;
        if (r < I_G) { tr_item(C.win + (size_t)l * D * INDIM, INDIM, 3592, 2048, D, Wb + W_G / 2, 1024, scr, r / 64, r % 64, C.lane, gl + 2 * D); continue; } r -= I_G;
        if (r < I_B) { tr_item(C.wbs + (size_t)l * 512 * D, D, 0, D, 512, Wb + W_BSB / 2, 0, scr, r / 32, r % 32, C.lane); continue; } r -= I_B;
        if (r < I_B) { tr_item(C.wbg + (size_t)l * 512 * D, D, 0, D, 512, Wb + W_BGD / 2, 0, scr, r / 32, r % 32, C.lane); continue; } r -= I_B;
        tr_item(C.wout + (size_t)l * D * D, D, 0, D, D, Wb + W_OUT / 2, 0, scr, r / 32, r % 32, C.lane);
    }
}

struct InitRow { f32x4 v0, v1, v2, v3; };
__device__ __forceinline__ InitRow init_load(const Ctx& C, int r) { const float* src = ((r < MP) ? C.xp + (size_t)r * D : C.xs + (size_t)(r - MP) * D) + 4 * C.lane;
    InitRow t; t.v0 = *(const f32x4*)(src); t.v1 = *(const f32x4*)(src + 256); t.v2 = *(const f32x4*)(src + 512); t.v3 = *(const f32x4*)(src + 768); return t; }
__device__ __forceinline__ void init_finish(const Ctx& C, const InitRow& t, int r) {
    const f32x4 q = t.v0 * t.v0 + t.v1 * t.v1 + t.v2 * t.v2 + t.v3 * t.v3;
    const float rstd = 1.0f / sqrtf(wave_sum((q[0] + q[1]) + (q[2] + q[3])) * (1.f / D) + EPS);
    bf16* xn = C.XN + (size_t)r * D + 4 * C.lane; u32x2 w;
    w.x = pk2(t.v0[0], t.v0[1]); w.y = pk2(t.v0[2], t.v0[3]); *(u32x2*)(xn) = w; w.x = pk2(t.v1[0], t.v1[1]); w.y = pk2(t.v1[2], t.v1[3]); *(u32x2*)(xn + 256) = w;
    w.x = pk2(t.v2[0], t.v2[1]); w.y = pk2(t.v2[2], t.v2[3]); *(u32x2*)(xn + 512) = w; w.x = pk2(t.v3[0], t.v3[1]); w.y = pk2(t.v3[2], t.v3[3]); *(u32x2*)(xn + 768) = w;
    if (C.lane == 0) C.rs[r] = rstd;
}
__device__ __forceinline__ void row_init_phase(const Ctx& C) {
    const int gw = C.bid * 8 + C.wave, NGW = C.G * 8;
#pragma unroll 1
    for (int r0 = gw; r0 < M; r0 += 2 * NGW) { const int r1 = (r0 + NGW < M) ? r0 + NGW : r0;
        const InitRow ta = init_load(C, r0), tb = init_load(C, r1);
        init_finish(C, ta, r0); init_finish(C, tb, r1); }
}
template <int NS> __device__ __forceinline__ void thin_rows(const Ctx& C, const bf16* Y, float scale, const float* gpost, bool final_out, const float* part, int rbeg, int rend, int rstep) {
    f32x4 gp[4];
#pragma unroll
    for (int j = 0; j < 4; ++j) gp[j] = *(const f32x4*)(gpost + 4 * C.lane + 256 * j);
    for (int r = rbeg; r < rend; r += rstep) {
        bf16* xr = C.XN + (size_t)r * D; const bf16* yr = Y + (size_t)r * D;
        f32x4 yv[4]; float ss;
        if (r >= MP) {
            float q = 0.f;
#pragma unroll
            for (int j = 0; j < 4; ++j) { f32x4 pa[NS];
#pragma unroll
                for (int ks = 0; ks < NS; ++ks) pa[ks] = *(const f32x4*)(part + ((size_t)ks * 512 + (r - MP)) * 1024 + 4 * C.lane + 256 * j);
                f32x4 a = pa[0];
#pragma unroll
                for (int ks = 1; ks < NS; ++ks) a += pa[ks];
                yv[j] = a; q += (a[0] * a[0] + a[1] * a[1]) + (a[2] * a[2] + a[3] * a[3]); }
            ss = wave_sum(q);
        } else { float pv = (C.lane < 16) ? C.rowss[(size_t)r * 16 + C.lane] : 0.f;
            pv += __shfl_xor(pv, 8); pv += __shfl_xor(pv, 4); pv += __shfl_xor(pv, 2); pv += __shfl_xor(pv, 1);
            ss = __shfl(pv, 0);
#pragma unroll
            for (int j = 0; j < 4; ++j) { const u32x2 y = *(const u32x2*)(yr + 4 * C.lane + 256 * j); yv[j] = (f32x4){bflo(y.x), bfhi(y.x), bflo(y.y), bfhi(y.y)}; } }
        const float rsy = scale / sqrtf(ss * (1.f / D) + EPS);
        f32x4 v[4]; float s = 0.f;
#pragma unroll
        for (int j = 0; j < 4; ++j) { const u32x2 x = *(const u32x2*)(xr + 4 * C.lane + 256 * j);
            v[j][0] = bflo(x.x) + yv[j][0] * rsy * gp[j][0]; v[j][1] = bfhi(x.x) + yv[j][1] * rsy * gp[j][1]; v[j][2] = bflo(x.y) + yv[j][2] * rsy * gp[j][2]; v[j][3] = bfhi(x.y) + yv[j][3] * rsy * gp[j][3];
            s += (v[j][0] * v[j][0] + v[j][1] * v[j][1]) + (v[j][2] * v[j][2] + v[j][3] * v[j][3]); }
        const float rstd = 1.0f / sqrtf(wave_sum(s) * (1.f / D) + EPS);
        if (C.lane == 0) C.rs[r] = rstd;
        float* xo = C.out + O_Y + (size_t)r * D;
#pragma unroll
        for (int j = 0; j < 4; ++j) { u32x2 w; w.x = pk2(v[j][0], v[j][1]); w.y = pk2(v[j][2], v[j][3]); *(u32x2*)(xr + 4 * C.lane + 256 * j) = w;
            if (final_out) *(f32x4*)(xo + 4 * C.lane + 256 * j) = v[j]; }
    }
}
struct ThinRow { u32x2 x0, x1, x2, x3, y0, y1, y2, y3; float pv; };
__device__ __forceinline__ ThinRow thin_load(const Ctx& C, const bf16* Y, int r) { ThinRow t; const bf16* xr = C.XN + (size_t)r * D + 4 * C.lane; const bf16* yr = Y + (size_t)r * D + 4 * C.lane;
    t.pv = (C.lane < 16) ? C.rowss[(size_t)r * 16 + C.lane] : 0.f;
    t.x0 = *(const u32x2*)(xr); t.x1 = *(const u32x2*)(xr + 256); t.x2 = *(const u32x2*)(xr + 512); t.x3 = *(const u32x2*)(xr + 768);
    t.y0 = *(const u32x2*)(yr); t.y1 = *(const u32x2*)(yr + 256); t.y2 = *(const u32x2*)(yr + 512); t.y3 = *(const u32x2*)(yr + 768); return t; }
__device__ __forceinline__ void thin_finish(const Ctx& C, const ThinRow& t, int r, float scale, const f32x4& g0, const f32x4& g1, const f32x4& g2, const f32x4& g3, bool final_out) {
    float p = t.pv; p += __shfl_xor(p, 8); p += __shfl_xor(p, 4); p += __shfl_xor(p, 2); p += __shfl_xor(p, 1);
    const float rsy = scale / sqrtf(__shfl(p, 0) * (1.f / D) + EPS);
#define TH_ROW(XX, YY, GG) (f32x4){bflo(XX.x) + bflo(YY.x) * rsy * GG[0], bfhi(XX.x) + bfhi(YY.x) * rsy * GG[1], bflo(XX.y) + bflo(YY.y) * rsy * GG[2], bfhi(XX.y) + bfhi(YY.y) * rsy * GG[3]}
    const f32x4 v0 = TH_ROW(t.x0, t.y0, g0), v1 = TH_ROW(t.x1, t.y1, g1), v2 = TH_ROW(t.x2, t.y2, g2), v3 = TH_ROW(t.x3, t.y3, g3);
#undef TH_ROW
    const f32x4 q = v0 * v0 + v1 * v1 + v2 * v2 + v3 * v3;
    const float rstd = 1.0f / sqrtf(wave_sum((q[0] + q[1]) + (q[2] + q[3])) * (1.f / D) + EPS);
    bf16* xr = C.XN + (size_t)r * D + 4 * C.lane; float* xo = C.out + O_Y + (size_t)r * D + 4 * C.lane;
    if (!final_out) { if (C.lane == 0) C.rs[r] = rstd; u32x2 w;     w.x = pk2(v0[0], v0[1]); w.y = pk2(v0[2], v0[3]); *(u32x2*)(xr) = w; w.x = pk2(v1[0], v1[1]); w.y = pk2(v1[2], v1[3]); *(u32x2*)(xr + 256) = w;
      w.x = pk2(v2[0], v2[1]); w.y = pk2(v2[2], v2[3]); *(u32x2*)(xr + 512) = w; w.x = pk2(v3[0], v3[1]); w.y = pk2(v3[2], v3[3]); *(u32x2*)(xr + 768) = w; }
    if (final_out) { *(f32x4*)(xo) = v0; *(f32x4*)(xo + 256) = v1; *(f32x4*)(xo + 512) = v2; *(f32x4*)(xo + 768) = v3; }
}
__device__ __forceinline__ void thin_rows2(const Ctx& C, const bf16* Y, float scale, const float* gpost, bool final_out, int rbeg, int rend, int rstep) {
    const f32x4 g0 = *(const f32x4*)(gpost + 4 * C.lane), g1 = *(const f32x4*)(gpost + 4 * C.lane + 256), g2 = *(const f32x4*)(gpost + 4 * C.lane + 512), g3 = *(const f32x4*)(gpost + 4 * C.lane + 768);
#pragma unroll 1
    for (int r0 = rbeg; r0 < rend; r0 += 2 * rstep) {
        const int r1 = (r0 + rstep < rend) ? r0 + rstep : r0;
        const ThinRow ta = thin_load(C, Y, r0), tb = thin_load(C, Y, r1);
        asm volatile("" ::: "memory");
        thin_finish(C, ta, r0, scale, g0, g1, g2, g3, final_out); thin_finish(C, tb, r1, scale, g0, g1, g2, g3, final_out);
    }
}
template <int NS> __device__ __forceinline__ void thin_phase(const Ctx& C, const bf16* Y, float scale, const float* gpost, bool final_out) {
    thin_rows2(C, Y, scale, gpost, final_out, C.bid * 8 + C.wave, MP, C.G * 8);
    thin_rows<NS>(C, Y, scale, gpost, final_out, (const float*)C.OR, MP + C.bid * 8 + C.wave, M, C.G * 8);
}
__device__ __forceinline__ void gdn_norm_row(const Ctx& C, int r, const u32x4& ov, const u32x4& zv, const f32x4& g0, const f32x4& g1) {
    float o[8], z[8];
#pragma unroll
    for (int e = 0; e < 4; ++e) { o[2 * e] = bflo(ov[e]); o[2 * e + 1] = bfhi(ov[e]); z[2 * e] = bflo(zv[e]); z[2 * e + 1] = bfhi(zv[e]); }
    float ss = 0.f;
#pragma unroll
    for (int e = 0; e < 8; ++e) ss += o[e] * o[e];
    ss += __shfl_xor(ss, 1); ss += __shfl_xor(ss, 2); ss += __shfl_xor(ss, 4); ss += __shfl_xor(ss, 8);
    const float rstd = 1.0f / sqrtf(ss * (1.f / 128.f) + EPS);
    f32x4 r0, r1;
#pragma unroll
    for (int e = 0; e < 4; ++e) { r0[e] = o[e] * rstd * g0[e] * z[e] * sigm(z[e]); r1[e] = o[4 + e] * rstd * g1[e] * z[4 + e] * sigm(z[4 + e]); }
    *(u32x4*)(C.P + (size_t)r * PIN + 3072 + C.lane * 8) = pg8::pack8(r0, r1);
}
__device__ __forceinline__ void gdn_norm_phase(const Ctx& C, int l) {
    const int gw = C.bid * 8 + C.wave, NGW = C.G * 8;
    const float* gain = C.gng + l * 128 + (C.lane & 15) * 8;
    const f32x4 g0 = *(const f32x4*)gain, g1 = *(const f32x4*)(gain + 4);
#pragma unroll 1
    for (int r0 = gw; r0 < M; r0 += 2 * NGW) { const int r1 = (r0 + NGW < M) ? r0 + NGW : r0;
        const u32x4 oa = *(const u32x4*)(C.OR + (size_t)r0 * 512 + C.lane * 8), za = *(const u32x4*)(C.P + (size_t)r0 * PIN + 3072 + C.lane * 8);
        const u32x4 ob = *(const u32x4*)(C.OR + (size_t)r1 * 512 + C.lane * 8), zb = *(const u32x4*)(C.P + (size_t)r1 * PIN + 3072 + C.lane * 8);
        asm volatile("" ::: "memory");
        gdn_norm_row(C, r0, oa, za, g0, g1); gdn_norm_row(C, r1, ob, zb, g0, g1); }
}

constexpr int PRE_U = 0, PRE_QN = 65536, PRE_KN = 82944, PRE_AF = 100352, PRE_RN = 117760, PRE_GC = 118272, PRE_BE = 118528;
__device__ __forceinline__ void gdn_pre_unit(const Ctx& C, int l, int n, int h, unsigned char* lds) {
    int tid_ = C.tid; asm volatile("" : "+v"(tid_));
    const int tid = tid_, lane = tid & 63, wave = __builtin_amdgcn_readfirstlane(tid >> 6);
    float* U = (float*)(lds + PRE_U); bf16* QN = (bf16*)(lds + PRE_QN); bf16* KN = (bf16*)(lds + PRE_KN); float* AF = (float*)(lds + PRE_AF);
    float* RN = (float*)(lds + PRE_RN); float* GC = (float*)(lds + PRE_GC); float* BE = (float*)(lds + PRE_BE);
    const int row0 = n * 64; const bool isS = n >= 512; const int sb = n - 512;
    const bool seq_first = isS ? true : ((n & 127) == 0); const bool seq_last = isS ? true : ((n & 127) == 127);
    unsigned char* rec = C.YT + (size_t)(n * 4 + h) * 65536;
    if (tid < 384) {
        const int cgp = tid % 48, rs = tid / 48, part = cgp >> 4, c8 = (cgp & 15) * 8, cc = part * 512 + h * 128 + c8;
        float w[4][8];
#pragma unroll
        for (int i = 0; i < 4; ++i) { const f32x4 a = *(const f32x4*)(C.convw + (size_t)(l * 4 + i) * 1536 + cc), b = *(const f32x4*)(C.convw + (size_t)(l * 4 + i) * 1536 + cc + 4);
#pragma unroll
            for (int e = 0; e < 4; ++e) { w[i][e] = a[e]; w[i][4 + e] = b[e]; } }
        float win[3][8];
#pragma unroll
        for (int i = 0; i < 3; ++i) { const int rr = 8 * rs - 3 + i;
            if (rr >= 0 || !seq_first) { const u32x4 v = *(const u32x4*)(C.P + (size_t)(row0 + rr) * PIN + 1536 + cc);
#pragma unroll
                for (int e = 0; e < 4; ++e) { win[i][2 * e] = bflo(v[e]); win[i][2 * e + 1] = bfhi(v[e]); } }
            else if (isS) { const float* sc = C.state_conv + ((size_t)(l * 8 + sb) * 3 + (3 + rr)) * 1536 + cc; const f32x4 a = *(const f32x4*)sc, b = *(const f32x4*)(sc + 4);
#pragma unroll
                for (int e = 0; e < 4; ++e) { win[i][e] = a[e]; win[i][4 + e] = b[e]; } }
            else {
#pragma unroll
                for (int e = 0; e < 8; ++e) win[i][e] = 0.f; } }
#pragma unroll
        for (int rr = 0; rr < 8; ++rr) { const int r = 8 * rs + rr; const u32x4 v = *(const u32x4*)(C.P + (size_t)(row0 + r) * PIN + 1536 + cc);
            float cur[8], y[8];
#pragma unroll
            for (int e = 0; e < 4; ++e) { cur[2 * e] = bflo(v[e]); cur[2 * e + 1] = bfhi(v[e]); }
#pragma unroll
            for (int e = 0; e < 8; ++e) { const float t = win[0][e] * w[0][e] + win[1][e] * w[1][e] + win[2][e] * w[2][e] + cur[e] * w[3][e]; y[e] = t * sigm(t);
                win[0][e] = win[1][e]; win[1][e] = win[2][e]; win[2][e] = cur[e]; }
            if (part < 2) { *(f32x4*)(U + r * 256 + part * 128 + c8) = (f32x4){y[0], y[1], y[2], y[3]}; *(f32x4*)(U + r * 256 + part * 128 + c8 + 4) = (f32x4){y[4], y[5], y[6], y[7]}; }
            else { u32x4 o; o.x = pk2(y[0], y[1]); o.y = pk2(y[2], y[3]); o.z = pk2(y[4], y[5]); o.w = pk2(y[6], y[7]); *(u32x4*)(rec + 32768 + (size_t)(r * 128 + c8) * 2) = o; }
            if (seq_last && r >= 61) { float* o = C.out + (isS ? O_CS + ((size_t)(l * 8 + sb) * 3 + (r - 61)) * 1536 : O_CP + ((size_t)(l * 4 + (n >> 7)) * 3 + (r - 61)) * 1536) + cc;
                *(f32x4*)o = (f32x4){cur[0], cur[1], cur[2], cur[3]}; *(f32x4*)(o + 4) = (f32x4){cur[4], cur[5], cur[6], cur[7]}; }
        }
    } else if (wave == 7) {
        const float bl = b2f(C.P[(size_t)(row0 + lane) * PIN + 3584 + h]), al = b2f(C.P[(size_t)(row0 + lane) * PIN + 3588 + h]);
        const float beta = sigm(bl); const float xa = al + C.dtb[l * 4 + h];
        const float sp = fmaxf(xa, 0.f) + log1pf(expf(-fabsf(xa)));
        float g = -expf(C.alog[l * 4 + h]) * sp;
#pragma unroll
        for (int o = 1; o < 64; o <<= 1) { const float t = __shfl_up(g, o); if (lane >= o) g += t; }
        GC[lane] = g; BE[lane] = beta; C.gc[(size_t)(n * 4 + h) * 64 + lane] = g; C.be[(size_t)(n * 4 + h) * 64 + lane] = beta;
    }
    lds_barrier();
    { const int r = tid >> 3, sub = tid & 7, part = sub >> 2, qt = sub & 3; const float* u = U + r * 256 + part * 128 + 32 * qt; f32x4 v[8]; float ss = 0.f;
#pragma unroll
        for (int i = 0; i < 8; ++i) { v[i] = *(const f32x4*)(u + 4 * i); ss += (v[i][0] * v[i][0] + v[i][1] * v[i][1]) + (v[i][2] * v[i][2] + v[i][3] * v[i][3]); }
        ss += __shfl_xor(ss, 1); ss += __shfl_xor(ss, 2);
        float rn = 1.0f / sqrtf(ss + EPS); if (part == 0) rn *= 0.08838834764831845f;
        bf16* dl = (part ? KN : QN) + r * 136 + 32 * qt; unsigned char* dg = rec + (part ? 16384 : 0) + (size_t)(r * 128 + 32 * qt) * 2;
#pragma unroll
        for (int i = 0; i < 4; ++i) { const u32x4 o = pg8::pack8(v[2 * i] * rn, v[2 * i + 1] * rn); *(u32x4*)(dl + 8 * i) = o; *(u32x4*)(dg + 16 * i) = o; } }
    lds_barrier();
    { const int p = wave >> 2, mt = wave & 3, lc = lane & 15, lq = lane >> 4; const bf16* Ab = (p ? QN : KN) + (16 * mt + lc) * 136 + 8 * lq;
        bf16x8 af[4];
#pragma unroll
        for (int ks = 0; ks < 4; ++ks) af[ks] = *(const bf16x8*)(Ab + 32 * ks);
#pragma unroll
        for (int nt = 0; nt < 4; ++nt) { f32x4 acc = {0.f, 0.f, 0.f, 0.f};
            if (nt <= mt) {
#pragma unroll
                for (int ks = 0; ks < 4; ++ks) acc = mfma16(af[ks], *(const bf16x8*)(KN + (16 * nt + lc) * 136 + 32 * ks + 8 * lq), acc); }
            const int j = 16 * nt + lc; const float gj = GC[j];
#pragma unroll
            for (int rg = 0; rg < 4; ++rg) { const int i = 16 * mt + 4 * lq + rg; const float dec = (i >= j) ? __expf(GC[i] - gj) : 0.f;
                if (p == 0) AF[i * 68 + j] = (i > j) ? BE[i] * acc[rg] * dec : 0.f;
                else *(bf16*)(rec + 57344 + (size_t)(i * 64 + j) * 2) = f2b((i >= j) ? acc[rg] * dec : 0.f); } } }
    lds_barrier();
    { float* XF = U; float* TP = U + 5120 + wave * 272;
      const int lc = lane & 15, lq = lane >> 4;
      if (wave == 0) {
          const float* ab = AF + (16 * lq) * 68 + 16 * lq; float x[16];
#pragma unroll
          for (int i = 0; i < 16; ++i) { float sv = (i == lc) ? 1.f : 0.f;
#pragma unroll
              for (int j = 0; j < i; ++j) sv -= ab[i * 68 + j] * x[j];
              x[i] = sv; XF[(16 * lq + i) * 68 + 16 * lq + lc] = sv; asm volatile("" ::: "memory"); }
      } else {
          for (int e = tid - 64; e < 6 * 256; e += 448) { const int bk = e >> 8, w = e & 255; const int bi = (bk < 3) ? 0 : (bk < 5 ? 1 : 2), bj = (bk < 3) ? bk + 1 : (bk < 5 ? bk - 1 : 3);
              XF[(16 * bi + (w >> 4)) * 68 + 16 * bj + (w & 15)] = 0.f; } }
      lds_barrier();
#pragma unroll
      for (int lev = 1; lev < 4; ++lev) {
          if (wave < 4 - lev) { const int bi = wave + lev, bj = wave; f32x4 p = {0.f, 0.f, 0.f, 0.f};
              for (int k = bj; k < bi; ++k) {
#pragma unroll
                  for (int ks = 0; ks < 4; ++ks) p = __builtin_amdgcn_mfma_f32_16x16x4f32(AF[(16 * bi + lc) * 68 + 16 * k + 4 * ks + lq], XF[(16 * k + 4 * ks + lq) * 68 + 16 * bj + lc], p, 0, 0, 0); }
#pragma unroll
              for (int rg = 0; rg < 4; ++rg) TP[(4 * lq + rg) * 17 + lc] = p[rg];
              f32x4 x = {0.f, 0.f, 0.f, 0.f};
#pragma unroll
              for (int ks = 0; ks < 4; ++ks) x = __builtin_amdgcn_mfma_f32_16x16x4f32(XF[(16 * bi + lc) * 68 + 16 * bi + 4 * ks + lq], TP[(4 * ks + lq) * 17 + lc], x, 0, 0, 0);
#pragma unroll
              for (int rg = 0; rg < 4; ++rg) XF[(16 * bi + 4 * lq + rg) * 68 + 16 * bj + lc] = -x[rg]; }
          lds_barrier();
      }
      { const int r = tid >> 3, c8 = (tid & 7) * 8; const f32x4 a = *(const f32x4*)(XF + r * 68 + c8), b = *(const f32x4*)(XF + r * 68 + c8 + 4);
        *(u32x4*)(rec + 49152 + (size_t)(r * 64 + c8) * 2) = pg8::pack8(a, b); }
    }
    lds_barrier();
}

constexpr int SC_SET = 58880, SC_KN = 0, SC_QN = 17408, SC_TI = 34816, SC_QK = 44032, SC_VSL = 53248  , SC_GB = 58368  , SC_ST = 2 * SC_SET, SC_STSZ = 8192, SC_DT = SC_ST + 2 * SC_STSZ, SC_VN = SC_DT + 4096, SC_VS = SC_VN + 4096;
static_assert(SC_VS + 4096 <= LDS_Q, "scan LDS");
__device__ __forceinline__ void sc_load(const Ctx& C, int n, int h, int tid, int dv0, u32x4 (&pf)[8]) {
    const unsigned char* rec_ = C.YT + (size_t)(n * 4 + h) * 65536;
    pf[0] = *(const u32x4*)(rec_ + 16384 + (size_t)tid * 16); pf[1] = *(const u32x4*)(rec_ + 16384 + (size_t)(tid + 512) * 16);
    pf[2] = *(const u32x4*)(rec_ + (size_t)tid * 16); pf[3] = *(const u32x4*)(rec_ + (size_t)(tid + 512) * 16);
    pf[4] = *(const u32x4*)(rec_ + 49152 + (size_t)tid * 16); pf[5] = *(const u32x4*)(rec_ + 57344 + (size_t)tid * 16);
    { const int p = tid & 255; pf[6] = *(const u32x4*)(rec_ + 32768 + (size_t)((p >> 2) * 128 + dv0 + 8 * (p & 3)) * 2); }
    { const int q = tid & 31; pf[7] = *(const u32x4*)((q < 16 ? C.gc : C.be) + (size_t)(n * 4 + h) * 64 + (q & 15) * 4); }
}
__device__ __forceinline__ void sc_store(unsigned char* s_, int tid, const u32x4 (&pf)[8]) {
    *(u32x4*)(s_ + SC_KN + (tid >> 4) * 272 + (tid & 15) * 16) = pf[0]; *(u32x4*)(s_ + SC_KN + (32 + (tid >> 4)) * 272 + (tid & 15) * 16) = pf[1];
    *(u32x4*)(s_ + SC_QN + (tid >> 4) * 272 + (tid & 15) * 16) = pf[2]; *(u32x4*)(s_ + SC_QN + (32 + (tid >> 4)) * 272 + (tid & 15) * 16) = pf[3];
    *(u32x4*)(s_ + SC_TI + (tid >> 3) * 144 + (tid & 7) * 16) = pf[4]; *(u32x4*)(s_ + SC_QK + (tid >> 3) * 144 + (tid & 7) * 16) = pf[5];
    if (tid < 256) *(u32x4*)(s_ + SC_VSL + (tid >> 2) * 80 + (tid & 3) * 16) = pf[6];
    if (tid < 32) *(u32x4*)(s_ + SC_GB + tid * 16) = pf[7];
}
typedef short v4i16_t __attribute__((ext_vector_type(4)));
__device__ __forceinline__ s16x4 vtr(const LAS unsigned char* p) { return __builtin_bit_cast(s16x4, __builtin_amdgcn_ds_read_tr16_b64_v4i16((LAS v4i16_t*)p)); }
__device__ __forceinline__ bf16x8 tr_frag(const LAS unsigned char* img, int rowb, int krow0, int col0, int lane) {
    const int g = lane >> 4, q = (lane & 15) >> 2, p = lane & 3;
    const LAS unsigned char* a = img + (krow0 + 8 * g + q) * rowb + (col0 + 4 * p) * 2;
    const s16x4 t0 = vtr(a), t1 = vtr(a + 4 * rowb);
    return (bf16x8){t0[0], t0[1], t0[2], t0[3], t1[0], t1[1], t1[2], t1[3]};
}
__device__ __forceinline__ void sc_step(const Ctx& C, unsigned char* lds, int cur, int n, int h, int dv0, int lane, int mt, int nt, f32x4 (&S)[2]) {
    const int lc = lane & 15, lq = lane >> 4, row0 = n * 64, i = 16 * nt + lc;
    const unsigned char* set = lds + cur * SC_SET; const LAS unsigned char* l3 = (const LAS unsigned char*)lds;
    const LAS unsigned char* STc = l3 + SC_ST + cur * SC_STSZ; unsigned char* STn = lds + SC_ST + (cur ^ 1) * SC_STSZ;
    const float* GB = (const float*)(set + SC_GB); const float gi = GB[i], bi = GB[64 + i], gl = GB[63]; const u32x2 vv = *(const u32x2*)(set + SC_VSL + i * 80 + (16 * mt + 4 * lq) * 2);
    const float eg = __expf(gi), ek = __expf(gl - gi), cd = __expf(gl);
    bf16x8 sa[4]; f32x4 acc = {0.f, 0.f, 0.f, 0.f};
#pragma unroll
    for (int ks = 0; ks < 4; ++ks) { sa[ks] = tr_frag(STc, 64, 32 * ks, 16 * mt, lane);
        acc = mfma16(sa[ks], *(const bf16x8*)(set + SC_KN + (16 * nt + lc) * 272 + (32 * ks + 8 * lq) * 2), acc); }
    { const float v0 = bflo(vv.x), v1 = bfhi(vv.x), v2 = bflo(vv.y), v3 = bfhi(vv.y);
        u32x2 d; d.x = pk2(bi * (v0 - acc[0] * eg), bi * (v1 - acc[1] * eg)); d.y = pk2(bi * (v2 - acc[2] * eg), bi * (v3 - acc[3] * eg));
        *(u32x2*)(lds + SC_DT + i * 64 + (16 * mt + 4 * lq) * 2) = d; }
    lds_barrier();
    f32x4 vn = {0.f, 0.f, 0.f, 0.f};
#pragma unroll
    for (int ks = 0; ks < 2; ++ks) vn = mfma16(tr_frag(l3 + SC_DT, 64, 32 * ks, 16 * mt, lane), *(const bf16x8*)(set + SC_TI + (16 * nt + lc) * 144 + (32 * ks + 8 * lq) * 2), vn);
    { u32x2 a, b; a.x = pk2(vn[0], vn[1]); a.y = pk2(vn[2], vn[3]); b.x = pk2(vn[0] * ek, vn[1] * ek); b.y = pk2(vn[2] * ek, vn[3] * ek);
        *(u32x2*)(lds + SC_VN + i * 64 + (16 * mt + 4 * lq) * 2) = a; *(u32x2*)(lds + SC_VS + i * 64 + (16 * mt + 4 * lq) * 2) = b; }
    lds_barrier();
    { bf16x8 va[2];
#pragma unroll
        for (int ks = 0; ks < 2; ++ks) va[ks] = tr_frag(l3 + SC_VS, 64, 32 * ks, 16 * mt, lane);
#pragma unroll
        for (int t = 0; t < 2; ++t) { const int dkt = 2 * nt + t; S[t] = S[t] * cd;
#pragma unroll
            for (int ks = 0; ks < 2; ++ks) S[t] = mfma16(va[ks], tr_frag(l3 + cur * SC_SET + SC_KN, 272, 32 * ks, 16 * dkt, lane), S[t]);
            u32x2 w; w.x = pk2(S[t][0], S[t][1]); w.y = pk2(S[t][2], S[t][3]);
            *(u32x2*)(STn + (16 * dkt + lc) * 64 + (16 * mt + 4 * lq) * 2) = w; } }
    { f32x4 a1 = {0.f, 0.f, 0.f, 0.f}, a2 = {0.f, 0.f, 0.f, 0.f};
#pragma unroll
        for (int ks = 0; ks < 4; ++ks) a1 = mfma16(sa[ks], *(const bf16x8*)(set + SC_QN + (16 * nt + lc) * 272 + (32 * ks + 8 * lq) * 2), a1);
#pragma unroll
        for (int ks = 0; ks < 2; ++ks) a2 = mfma16(tr_frag(l3 + SC_VN, 64, 32 * ks, 16 * mt, lane), *(const bf16x8*)(set + SC_QK + (16 * nt + lc) * 144 + (32 * ks + 8 * lq) * 2), a2);
        u32x2 o; o.x = pk2(a1[0] * eg + a2[0], a1[1] * eg + a2[1]); o.y = pk2(a1[2] * eg + a2[2], a1[3] * eg + a2[3]);
        *(u32x2*)(C.OR + (size_t)(row0 + i) * 512 + h * 128 + dv0 + 16 * mt + 4 * lq) = o; }
}
__device__ __forceinline__ void scan_unit(const Ctx& C, int l, int isS, int b, int h, int sl, unsigned char* lds, const XcdBarrier* xb) {
    const int tid = C.tid, lane = C.lane, wave = C.wave, lc = lane & 15, lq = lane >> 4, mt = wave & 1, nt = wave >> 1;
    const int nch = isS ? 1 : 128, n0 = isS ? 512 + b : 128 * b, dv0 = 32 * sl;
    f32x4 S[2];
#pragma unroll
    for (int t = 0; t < 2; ++t) { const int dk = 16 * (2 * nt + t) + lc;
        S[t] = isS ? *(const f32x4*)(C.state_gdn + ((size_t)((l * 8 + b) * 4 + h) * 128 + dk) * 128 + dv0 + 16 * mt + 4 * lq) : (f32x4){0.f, 0.f, 0.f, 0.f};
        { u32x2 w; w.x = pk2(S[t][0], S[t][1]); w.y = pk2(S[t][2], S[t][3]); *(u32x2*)(lds + SC_ST + (16 * (2 * nt + t) + lc) * 64 + (16 * mt + 4 * lq) * 2) = w; } }
    u32x4 pfA[8], pfB[8];
    sc_load(C, n0, h, tid, dv0, pfA); sc_store(lds, tid, pfA);
    if (nch == 1) {
        lds_barrier();
        sc_step(C, lds, 0, n0, h, dv0, lane, mt, nt, S);
        lds_barrier();
    } else {
#pragma unroll 1
        for (int half = 0; half < 4; ++half) { const int cb = 32 * half, nlast = n0 + cb + 31;
            if (half) { xcd_barrier(*xb); sc_load(C, n0 + cb, h, tid, dv0, pfA); sc_store(lds, tid, pfA); }
            sc_load(C, n0 + cb + 1, h, tid, dv0, pfB);
            lds_barrier();
            for (int c = cb; c < cb + 32; c += 2) {
                sc_load(C, min(n0 + c + 2, nlast), h, tid, dv0, pfA);
                sc_step(C, lds, 0, n0 + c, h, dv0, lane, mt, nt, S);
                sc_store(lds + SC_SET, tid, pfB);
                lds_barrier();
                sc_load(C, min(n0 + c + 3, nlast), h, tid, dv0, pfB);
                sc_step(C, lds, 1, n0 + c + 1, h, dv0, lane, mt, nt, S);
                sc_store(lds, tid, pfA);
                lds_barrier();
            }
        }
    }
    float* so = C.out + (isS ? O_GS + (size_t)((l * 8 + b) * 4 + h) * 16384 : O_GP + (size_t)((l * 4 + b) * 4 + h) * 16384);
#pragma unroll
    for (int t = 0; t < 2; ++t) *(f32x4*)(so + (size_t)(16 * (2 * nt + t) + lc) * 128 + dv0 + 16 * mt + 4 * lq) = S[t];
}

constexpr int AT_K = 0, AT_V = 8192, AT_FL = 16384;
__device__ __forceinline__ int crow(int r, int hi) { return (r & 3) + 8 * (r >> 2) + 4 * hi; }
__device__ __forceinline__ void sb_block(f32x16& p, int keybase, int qp, bool mask, float& carry, int hi) {
    float G[4];
#pragma unroll
    for (int g = 0; g < 4; ++g) { float kp[4], be[4];
#pragma unroll
        for (int e = 0; e < 4; ++e) { const float z = p[4 * g + e]; const float ex = __builtin_amdgcn_exp2f(-fabsf(z) * (0.125f * LOG2E)); const float r = __builtin_amdgcn_rcpf(1.f + ex); const float er = ex * r;
            const bool pos = z >= 0.f; float bt = pos ? r : er, kv = pos ? er : r;
            if (mask) { const int key = keybase + 8 * g + 4 * hi + e; if (key >= qp) { bt = 0.f; kv = 1.f; } }
            kp[e] = kv; be[e] = bt; }
        const float s2 = kp[3], s1 = kp[3] * kp[2], s0 = s1 * kp[1]; G[g] = s0 * kp[0];
        p[4 * g + 3] = be[3]; p[4 * g + 2] = be[2] * s2; p[4 * g + 1] = be[1] * s1; p[4 * g] = be[0] * s0; }
    float run = carry;
#pragma unroll
    for (int g = 3; g >= 0; --g) { const auto sw = __builtin_amdgcn_permlane32_swap(__float_as_uint(G[g]), __float_as_uint(G[g]), false, false);
        const float gp = __uint_as_float(hi ? sw[0] : sw[1]); const float aft = hi ? run : run * gp;
#pragma unroll
        for (int e = 0; e < 4; ++e) p[4 * g + e] *= aft;
        run *= G[g] * gp; }
    carry = run;
}
__device__ __forceinline__ void attn_unit(const Ctx& C, int l, int isS, int b, int h, int qb, unsigned char* lds) {
    const int tid = C.tid, lane = C.lane, wid = C.wave, r32 = lane & 31, hi = lane >> 5;
    bf16* P = C.P;
    const int q_row0 = isS ? MP + 64 * b : b * SEQ + 256 * qb, qpos0 = isS ? PAST : 256 * qb, nq = isS ? 64 : 256;
    const int kv_pos0 = isS ? PAST : 0, kv_row0 = isS ? MP + 64 * b : b * SEQ;
    const float* Kc = C.cache_k + (size_t)(l * 8 + b) * PAST * 512 + h * 64; const float* Vc = C.cache_v + (size_t)(l * 8 + b) * PAST * 512 + h * 64;
    const int T_top = (qpos0 + nq - 2) >> 6; const bool wact = 32 * wid < nq; const int wtop = (qpos0 + 32 * wid + 30) >> 6;
    bf16x8 qr[4];
#pragma unroll
    for (int d0 = 0; d0 < 4; ++d0) qr[d0] = wact ? *(const bf16x8*)(P + (size_t)(q_row0 + 32 * wid + r32) * PIN + h * 64 + d0 * 16 + hi * 8) : (bf16x8){0, 0, 0, 0, 0, 0, 0, 0};
    f32x16 o[2]; o[0] = f32x16{}; o[1] = f32x16{};
    float carry = 1.f; bool wdone = false;
    u32x4 kreg, vreg;
#define AT_LOAD(t_) do { const int pos0_ = 64 * (t_); \
        if (pos0_ >= kv_pos0) { kreg = *(const u32x4*)(P + (size_t)(kv_row0 + pos0_ - kv_pos0 + lane) * PIN + 512 + h * 64 + wid * 8); \
                                vreg = *(const u32x4*)(P + (size_t)(kv_row0 + pos0_ - kv_pos0 + (tid >> 3)) * PIN + 1024 + h * 64 + (tid & 7) * 8); } \
        else { const float* kp_ = Kc + (size_t)(pos0_ + lane) * 512 + wid * 8; kreg = pg8::pack8(*(const f32x4*)kp_, *(const f32x4*)(kp_ + 4)); \
               const float* vp_ = Vc + (size_t)(pos0_ + (tid >> 3)) * 512 + (tid & 7) * 8; vreg = pg8::pack8(*(const f32x4*)vp_, *(const f32x4*)(vp_ + 4)); } } while (0)
    AT_LOAD(T_top);
    const LAS unsigned char* l3 = (const LAS unsigned char*)lds;
    const int voff = ((lane >> 4) & 1) * 32 + (lane & 3) * 8 + (4 * hi + ((lane & 15) >> 2)) * 64;
    float* fl = (float*)(lds + AT_FL);
    for (int t = T_top; t >= 0; --t) {
        *(u32x4*)(lds + AT_K + wid * 1024 + lane * 16) = kreg;
        *(u32x4*)(lds + AT_V + ((tid & 7) >> 2) * 4096 + (tid >> 3) * 64 + (tid & 3) * 16) = vreg;
        lds_barrier();
        if (t > 0) AT_LOAD(t - 1);
        if (wact && t <= wtop && !wdone) {
            f32x16 p0 = f32x16{}, p1 = f32x16{};
#pragma unroll
            for (int d0 = 0; d0 < 4; ++d0) { const bf16x8 k0 = *(const bf16x8*)(lds + AT_K + (2 * d0 + hi) * 1024 + r32 * 16), k1 = *(const bf16x8*)(lds + AT_K + (2 * d0 + hi) * 1024 + r32 * 16 + 512);
                p0 = mfma32(k0, qr[d0], p0); p1 = mfma32(k1, qr[d0], p1); }
            const int qp = qpos0 + 32 * wid + r32; const bool mask = (64 * t + 63 >= qpos0 + 32 * wid);
            sb_block(p1, 64 * t + 32, qp, mask, carry, hi);
            sb_block(p0, 64 * t, qp, mask, carry, hi);
            bf16x8 pw[4];
            { u32x4 w; w.x = pk2(p0[0], p0[1]); w.y = pk2(p0[2], p0[3]); w.z = pk2(p0[4], p0[5]); w.w = pk2(p0[6], p0[7]); pw[0] = __builtin_bit_cast(bf16x8, w);
              w.x = pk2(p0[8], p0[9]); w.y = pk2(p0[10], p0[11]); w.z = pk2(p0[12], p0[13]); w.w = pk2(p0[14], p0[15]); pw[1] = __builtin_bit_cast(bf16x8, w);
              w.x = pk2(p1[0], p1[1]); w.y = pk2(p1[2], p1[3]); w.z = pk2(p1[4], p1[5]); w.w = pk2(p1[6], p1[7]); pw[2] = __builtin_bit_cast(bf16x8, w);
              w.x = pk2(p1[8], p1[9]); w.y = pk2(p1[10], p1[11]); w.z = pk2(p1[12], p1[13]); w.w = pk2(p1[14], p1[15]); pw[3] = __builtin_bit_cast(bf16x8, w); }
#pragma unroll
            for (int d0 = 0; d0 < 2; ++d0)
#pragma unroll
                for (int s = 0; s < 4; ++s) { const s16x4 a = vtr(l3 + AT_V + d0 * 4096 + s * 1024 + voff), c2 = vtr(l3 + AT_V + d0 * 4096 + s * 1024 + 512 + voff);
                    const bf16x8 vf = (bf16x8){a[0], a[1], a[2], a[3], c2[0], c2[1], c2[2], c2[3]};
                    o[d0] = mfma32(pw[s], vf, o[d0]); }
        }
        { const bool alive = wact && __builtin_amdgcn_ballot_w64(carry >= 1e-30f) != 0ull;
          wdone = !alive;
          if (lane == 0) fl[wid] = alive ? 1.f : 0.f; }
        lds_barrier();
        float mx = 0.f;
#pragma unroll
        for (int w = 0; w < 8; ++w) mx = fmaxf(mx, fl[w]);
        if (mx == 0.f) break;
    }
#undef AT_LOAD
    if (wact) {
#pragma unroll
        for (int d0 = 0; d0 < 2; ++d0)
#pragma unroll
            for (int r = 0; r < 16; ++r) P[(size_t)(q_row0 + 32 * wid + crow(r, hi)) * PIN + h * 64 + 32 * d0 + r32] = f2b(o[d0][r]);
    }
    lds_barrier();
}

#ifndef PHMASK
#define PHMASK 0xffff
#endif
#define HAS(k) (((PHMASK) >> (k)) & 1)
#ifndef PROBE_SEL
#define PROBE_SEL 0
#endif
#define MKCTX Ctx C; C.xp = ap->in[0]; C.xs = ap->in[1]; C.cache_k = ap->in[2]; C.cache_v = ap->in[3]; C.state_gdn = ap->in[4]; C.state_conv = ap->in[5]; C.gains = ap->in[6]; C.w1u = ap->in[7]; C.w1d = ap->in[8]; C.win = ap->in[9]; C.convw = ap->in[10]; C.alog = ap->in[11]; C.dtb = ap->in[12]; C.gng = ap->in[13]; C.wbs = ap->in[14]; C.wbg = ap->in[15]; C.wout = ap->in[16]; C.w2u = ap->in[17]; C.w2d = ap->in[18]; C.out = out_; C.ws = ws_; C.ctl = (unsigned*)(ws_ + WS_CTL); C.rowss = (float*)(ws_ + WS_ROWSS); C.gc = (float*)(ws_ + WS_GC); C.be = (float*)(ws_ + WS_BE); C.rs = (float*)(ws_ + WS_RS); C.XN = (bf16*)(ws_ + WS_XN); C.P = (bf16*)(ws_ + WS_R1); C.ACT = (bf16*)(ws_ + WS_R1); C.YT = ws_ + WS_YT; C.OR = (bf16*)(ws_ + WS_OR); C.tid = tid_; C.lane = C.tid & 63; C.wave = __builtin_amdgcn_readfirstlane(C.tid >> 6); C.G = gridDim.x; C.bid = bid_; LAS unsigned char* lds3 = (LAS unsigned char*)lds; bf16* Wb = (bf16*)(ws_ + WS_W); bf16* Y0 = (bf16*)C.YT; bf16* Y1 = (bf16*)(C.YT + YT_HALF);
template <int ph> __device__ __forceinline__ unsigned long long run_phase(unsigned char* lds, const XcdBarrier& xbar, int wv) {
    unsigned long long tsel = 0ull;
    constexpr int l = (ph - 1) / 14, q = (ph - 1) % 14;
    const __attribute__((address_space(4))) Args* ap = (const __attribute__((address_space(4))) Args*)__builtin_amdgcn_kernarg_segment_ptr();
    int tid_ = wv * 64 + (int)__builtin_amdgcn_mbcnt_hi(~0u, __builtin_amdgcn_mbcnt_lo(~0u, 0u)); int bid_ = blockIdx.x;
    asm volatile("" : "+s"(ap), "+v"(tid_), "+s"(bid_));
    unsigned char* ws_ = ap->ws; float* out_ = ap->out;
    LAS unsigned char* lds3 = (LAS unsigned char*)lds;
    bf16* Wb = (bf16*)(ws_ + WS_W); bf16* Y0 = (bf16*)(ws_ + WS_YT); bf16* Y1 = (bf16*)(ws_ + WS_YT + YT_HALF);
        if constexpr (HAS(0) && ph == 0) { MKCTX; convert_weights(C, 0, lds3); row_init_phase(C); }
        else if constexpr (HAS(1) && (q == 0 || q == 11)) { MKCTX;
            pg8::Gemm g{C.XN, Wb + (q == 0 ? W_UP1 : W_UP2) / 2, M, NUP, D, D, D}; pg8::StaticOrder S; S.init(M, NUP, C.G, C.bid);
            pg8::EpiSwiglu E{C.ACT, FF, C.rs}; pg8::gemm_phase<pg8::EpiSwiglu, pg8::StaticOrder, true, true>(lds3, g, S, E, C.tid);
        } else if constexpr (HAS(2) && (q == 1 || q == 12 || q == 9)) { MKCTX;
            const bf16* A = (q == 9) ? Y0 : C.ACT; const int K = (q == 9) ? D : FF; bf16* O = (q == 9) ? Y1 : Y0; const bf16* W = Wb + (q == 1 ? W_DN1 : q == 12 ? W_DN2 : W_OUT) / 2;
            { pg8::Gemm g{A, W, MP, D, K, K, K}; pg8::StaticOrder S; S.init(MP, D, C.G, C.bid);
              pg8::EpiYss E{O, C.rowss}; pg8::gemm_phase<pg8::EpiYss, pg8::StaticOrder, true, true>(lds3, g, S, E, C.tid); }
        } else if constexpr (HAS(3) && q == 2) { MKCTX; const float* gl = C.gains + (size_t)l * 6 * D; thin_phase<FF / 256>(C, Y0, 0.5f, gl + 1 * D, false); }
        else if constexpr (HAS(3) && q == 10) { MKCTX; const float* gl = C.gains + (size_t)l * 6 * D; thin_phase<D / 256>(C, Y1, 1.0f, gl + 3 * D, false); }
        else if constexpr (HAS(3) && q == 13) { MKCTX; const float* gl = C.gains + (size_t)l * 6 * D; if (l == 0) convert_weights(C, 1, lds3); thin_phase<FF / 256>(C, Y0, 0.5f, gl + 5 * D, l == 1); }
        else if constexpr (HAS(4) && q == 3) { MKCTX;
            pg8::Gemm g{C.XN, Wb + W_IN / 2, M, NINP, D, D, D}; pg8::StaticOrder S; S.init(M, NINP, C.G, C.bid);
            pg8::EpiIn E{C.P, PIN, C.out + O_KP + (size_t)l * MP * 512, C.out + O_VP + (size_t)l * MP * 512, C.out + O_KS + (size_t)l * MS * 512, C.out + O_VS + (size_t)l * MS * 512, MP, C.rs};
            pg8::gemm_phase<pg8::EpiIn, pg8::StaticOrder, true, true>(lds3, g, S, E, C.tid);
        } else if constexpr (HAS(5) && q == 4) { MKCTX;
            for (int u = C.bid; u < 512; u += C.G) { const int cc = u >> 2; gdn_pre_unit(C, l, 128 * (cc >> 5) + (cc & 31), u & 3, lds); } }
        else if constexpr ((HAS(6) || HAS(7)) && q == 5) { MKCTX;
            unsigned* qw = C.ctl + 64 * (1 + l); volatile unsigned* lq_ = (volatile unsigned*)(lds + LDS_Q);
            if (HAS(6) && C.bid < 64) {
                const unsigned long long tq0_ = PROBE_SEL ? __builtin_amdgcn_s_memrealtime() : 0ull;
                scan_unit(C, l, 0, C.bid >> 4, (C.bid >> 2) & 3, C.bid & 3, lds, &xbar);
                if (PROBE_SEL) tsel = __builtin_amdgcn_s_memrealtime() - tq0_; }
            int stage = (HAS(6) && C.bid < 64) ? 4 : 1;
            for (;;) {
                if (stage < 4) { const int nu = (stage == 3) ? 544 : 512;
                    for (int u = C.bid - 64; u < nu; u += C.G - 64) { const int cc = u >> 2;
                        if (u < 512) gdn_pre_unit(C, l, 128 * (cc >> 5) + 32 * stage + (cc & 31), u & 3, lds); else gdn_pre_unit(C, l, 512 + ((u - 512) >> 2), u & 3, lds); } }
                if (C.tid == 0) lq_[0] = atomicAdd(qw, 1u);
                lds_barrier();
                const int it = (int)lq_[0];
                lds_barrier();
                if (it < 1024 + 64 + 128) {
                    if (HAS(7) && it < 1024) attn_unit(C, l, 0, (it & 31) >> 3, it & 7, 31 - (it >> 5), lds);
                    else if (HAS(7) && it < 1088) { const int a = it - 1024; attn_unit(C, l, 1, a >> 3, a & 7, 0, lds); }
                    else if (HAS(6)) { const int s2 = it - 1088; scan_unit(C, l, 1, s2 >> 4, (s2 >> 2) & 3, s2 & 3, lds, nullptr); }
                } else if (stage >= 4) break;
                if (stage < 4) { xcd_barrier(xbar); ++stage; }
            }
        } else if constexpr (HAS(8) && q == 6) { MKCTX; gdn_norm_phase(C, l); }
        else if constexpr (HAS(9) && q == 7) { MKCTX;
#pragma unroll 1
            for (int br = 0; br < 2; ++br) { pg8::Gemm g{C.P + (br ? 3072 : 0), Wb + (br ? W_BGD : W_BSB) / 2, M, D, 512, PIN, 512}; pg8::StaticOrder S; S.init(M, D, C.G, C.bid); pg8::EpiPlain E{br ? Y1 : Y0, D};
              pg8::gemm_phase<pg8::EpiPlain, pg8::StaticOrder, true, true>(lds3, g, S, E, C.tid); }
        } else if constexpr (HAS(10) && q == 8) { MKCTX;
            pg8::Gemm g{C.XN, Wb + W_G / 2, M, NGATE, D, D, D}; pg8::StaticOrder S; S.init(M, NGATE, C.G, C.bid);
            pg8::EpiGate E{Y0, Y1, C.rs}; pg8::gemm_phase<pg8::EpiGate, pg8::StaticOrder, true, true>(lds3, g, S, E, C.tid);
        }
    return tsel;
}
template <int ph> __device__ __forceinline__ void run_phase_b(unsigned char* lds, int wv) {
    constexpr int l = (ph - 1) / 14, q = (ph - 1) % 14;
    if constexpr (HAS(2) && ph > 0 && (q == 1 || q == 12 || q == 9)) {
        const __attribute__((address_space(4))) Args* ap = (const __attribute__((address_space(4))) Args*)__builtin_amdgcn_kernarg_segment_ptr();
        int bid_ = blockIdx.x;
        asm volatile("" : "+s"(ap), "+s"(bid_));
        unsigned char* ws_ = ap->ws;
        const bf16* A = (q == 9) ? (const bf16*)(ws_ + WS_YT) : (const bf16*)(ws_ + WS_R1); constexpr int K = (q == 9) ? D : FF;
        const bf16* W = (const bf16*)(ws_ + WS_W) + (q == 1 ? W_DN1 : q == 12 ? W_DN2 : W_OUT) / 2;
        pg8::Gemm g{A + (size_t)MP * K, W, MS, D, 256, K, K}; pg8::SplitKOrder S{K / 256, (int)gridDim.x, bid_};
        pg8::EpiPart E{(float*)(ws_ + WS_OR)}; pg8::gemm_phase<pg8::EpiPart, pg8::SplitKOrder, true, true>((LAS unsigned char*)lds, g, S, E, wv * 64 + (int)__builtin_amdgcn_mbcnt_hi(~0u, __builtin_amdgcn_mbcnt_lo(~0u, 0u)));
    }
}
__global__ void __launch_bounds__(512, 2) fwd(Args args) {
    extern __shared__ __attribute__((aligned(16))) unsigned char lds[];
    const int lo = args.ph_lo, hi = args.ph_hi;
    const int wv = __builtin_amdgcn_readfirstlane(threadIdx.x >> 6);
    volatile LAS unsigned* xst = (volatile LAS unsigned*)((LAS unsigned char*)lds + LDS_Q + 16);
    if (threadIdx.x < 2) xst[threadIdx.x] = 0u;
    __syncthreads();
    (void)xcd_barrier_post((unsigned*)args.ws + 2048, xst);
#ifndef PROBE_MASK
#define PROBE_MASK 0u
#define PROBE_AMP 4
#endif
    unsigned long long tacc = 0ull;
#define RUN(P) if ((P) >= lo && (P) < hi) { XcdBarrier xbar; xbar.bar = (unsigned*)args.ws + 2048; xbar.x = xb_xcc_id(); xbar.st = xst; unsigned long long t0_ = 0ull; if ((PROBE_MASK >> (P)) & 1u) t0_ = __builtin_amdgcn_s_memrealtime(); \
        const unsigned long long ts_ = run_phase<P>(lds, xbar, wv); run_phase_b<P>(lds, wv); if (PROBE_SEL) tacc += ts_; if ((P) + 1 < hi) { if ((P) == 0 && lo < 0) cg::this_grid().sync(); else xcd_barrier(xbar); }     if ((PROBE_MASK >> (P)) & 1u) tacc += __builtin_amdgcn_s_memrealtime() - t0_; }
    RUN(0) RUN(1) RUN(2) RUN(3) RUN(4) RUN(5) RUN(6) RUN(7) RUN(8) RUN(9) RUN(10) RUN(11) RUN(12) RUN(13) RUN(14)
    RUN(15) RUN(16) RUN(17) RUN(18) RUN(19) RUN(20) RUN(21) RUN(22) RUN(23) RUN(24) RUN(25) RUN(26) RUN(27) RUN(28)
    if ((PROBE_MASK != 0u || PROBE_SEL) && blockIdx.x == 0 && threadIdx.x == 0) { const unsigned long long t1_ = __builtin_amdgcn_s_memrealtime(); while (__builtin_amdgcn_s_memrealtime() - t1_ < (unsigned long long)PROBE_AMP * tacc) __builtin_amdgcn_s_sleep(8); }
#undef RUN
}

#ifndef MK_SINGLE
#define MK_SINGLE 1
#endif
extern "C" void kernel_launch(void* const* d_in, const int* in_sizes, int n_in, void* d_out, int out_size, void* d_ws, size_t ws_size, hipStream_t stream) {
    static int grid = 0;
    if (grid == 0) {
        if (n_in != 19 || (size_t)out_size < O_END || ws_size < WS_END) { fprintf(stderr, "kernel_launch: unexpected shapes (n_in %d, out %d, ws %zu)\n", n_in, out_size, ws_size); grid = -1; return; }
        int dev = 0, cus = 0, per_cu = 0;
        hipGetDevice(&dev); hipDeviceGetAttribute(&cus, hipDeviceAttributeMultiprocessorCount, dev);
        if (hipFuncSetAttribute((const void*)fwd, hipFuncAttributeMaxDynamicSharedMemorySize, LDS_BYTES) != hipSuccess) { fprintf(stderr, "kernel_launch: hipFuncSetAttribute failed\n"); grid = -1; return; }
        hipOccupancyMaxActiveBlocksPerMultiprocessor(&per_cu, (const void*)fwd, 512, LDS_BYTES);
        if (per_cu < 1) { fprintf(stderr, "kernel_launch: occupancy query says %d\n", per_cu); per_cu = 1; }
        (void)hipGetLastError();
        grid = cus;
    }
    if (grid < 0) return;
    hipMemsetAsync((char*)d_ws + WS_CTL, 0, CTL_BYTES, stream);
    Args a{};
    for (int i = 0; i < 19; ++i) a.in[i] = (const float*)d_in[i];
    a.out = (float*)d_out; a.ws = (unsigned char*)d_ws;
#if MK_SINGLE
    a.ph_lo = 0; a.ph_hi = NPH;
    void* kargs[] = {&a};
    hipError_t e = hipLaunchCooperativeKernel((const void*)fwd, dim3(grid), dim3(512), kargs, LDS_BYTES, stream);
    if (e != hipSuccess) fprintf(stderr, "cooperative launch failed: %s (grid %d)\n", hipGetErrorString(e), grid);
#else
    for (int ph = 0; ph < NPH; ++ph) { a.ph_lo = ph; a.ph_hi = ph + 1; hipLaunchKernelGGL(fwd, dim3(grid), dim3(512), LDS_BYTES, stream, a); }
#endif
}
```

```cpp
#include <hip/hip_runtime.h>
#include <hip/hip_cooperative_groups.h>
#include <cstdio>
#include <cstdint>
namespace cg = cooperative_groups;
namespace pg8 {
#define PG8_LAS __attribute__((address_space(3)))
typedef unsigned short bf16_t;
typedef short bf16x8 __attribute__((ext_vector_type(8)));
typedef float f32x4 __attribute__((ext_vector_type(4)));
typedef unsigned u32x4 __attribute__((ext_vector_type(4)));
constexpr int BM = 256, BK = 64, HALF = 128, HTB = HALF * BK * 2  , STAGE_BYTES = 8 * HTB, NXCD = 8, WGM = 8;

__host__ __device__ __forceinline__ int lds_byte(int r, int c) { const int st = (r >> 4) * 2 + (c >> 5), rr = r & 15, cc = c & 31, ob = rr * 64 + cc * 2; return st * 1024 + (ob ^ (((ob >> 9) & 1) << 5)); }
__host__ __device__ __forceinline__ void stage_rc(int b, int& R, int& C) { const int st = b / 1024, sb = b % 1024, swz = sb ^ (((sb >> 9) & 1) << 5); R = (st >> 1) * 16 + swz / 64; C = (st & 1) * 32 + (swz % 64) / 2; }
__host__ __device__ __forceinline__ int perm32(int rho) { const int n = rho >> 4, i = rho & 15; return 8 * (i >> 2) + 4 * n + (i & 3); }

struct Unit { int pm, pn; int koff; };
struct Gemm { const bf16_t* A; const bf16_t* Bt; int M, N, K, lda, ldb; };

struct StaticOrder {
    int nM, nN, nwg, G, c;
    __host__ __device__ void init(int M, int N, int G_, int c_) { nM = M / BM; nN = N / BM; nwg = nM * nN; G = G_; c = c_; }
    __host__ __device__ bool next(int i, Unit& u) const {
        const long L = (long)i * G + c; if (L >= nwg) return false;
        int wgid = (int)L; { const int q = nwg / NXCD, r = nwg % NXCD, xcd = wgid % NXCD, off = wgid / NXCD; wgid = (xcd < r ? xcd * (q + 1) : r * (q + 1) + (xcd - r) * q) + off; }
        const int nig = WGM * nN, gid = wgid / nig, fm = gid * WGM, gsz = (nM - fm) < WGM ? (nM - fm) : WGM;
        u.pm = fm + ((wgid % nig) % gsz); u.pn = (wgid % nig) / gsz; u.koff = 0; return true;
    }
    __device__ __forceinline__ void a_ready(const Unit&) const {}
    __device__ __forceinline__ void done(const Unit&) const {}
};


__device__ __forceinline__ unsigned cvt_pk_bf16(float lo, float hi) { typedef float f2_ __attribute__((ext_vector_type(2))); typedef __bf16 b2_ __attribute__((ext_vector_type(2))); f2_ v = {lo, hi}; b2_ b = __builtin_convertvector(v, b2_); return __builtin_bit_cast(unsigned, b); }
__device__ __forceinline__ float bflo(unsigned u) { return __uint_as_float(u << 16); }
__device__ __forceinline__ float bfhi(unsigned u) { return __uint_as_float(u & 0xffff0000u); }
__device__ __forceinline__ float sigm(float x) { return __builtin_amdgcn_rcpf(1.f + __builtin_amdgcn_exp2f(-1.4426950408889634f * x)); }
__device__ __forceinline__ u32x4 pack8(const f32x4& a, const f32x4& b) { u32x4 w; w.x = cvt_pk_bf16(a[0], a[1]); w.y = cvt_pk_bf16(a[2], a[3]); w.z = cvt_pk_bf16(b[0], b[1]); w.w = cvt_pk_bf16(b[2], b[3]); return w; }

struct EpiPlain {
    static constexpr bool PERM = true, AFTER_DRAIN = false; bf16_t* O; int ldc;
    __device__ __forceinline__ void operator()(const f32x4 (&acc)[2][2][4][2], const Unit& u, int wr, int wc, int fr, int fq) const {
        const int row0 = u.pm * BM + wr * 64 + fr, col0 = u.pn * BM + wc * 32 + 8 * fq;
#pragma unroll
        for (int ai = 0; ai < 2; ++ai)
#pragma unroll
            for (int m = 0; m < 4; ++m) { bf16_t* rowp = O + (size_t)(row0 + ai * HALF + m * 16) * ldc + col0;
#pragma unroll
                for (int bj = 0; bj < 2; ++bj) *(u32x4*)(rowp + bj * HALF) = pack8(acc[ai][bj][m][0], acc[ai][bj][m][1]); }
    }
};
struct EpiSwiglu {
    static constexpr bool PERM = true, AFTER_DRAIN = false; bf16_t* O; int ldc; const float* rs;
    __device__ __forceinline__ void operator()(const f32x4 (&acc)[2][2][4][2], const Unit& u, int wr, int wc, int fr, int fq) const {
        const int row0 = u.pm * BM + wr * 64 + fr, col0 = u.pn * HALF + wc * 32 + 8 * fq;
#pragma unroll
        for (int ai = 0; ai < 2; ++ai)
#pragma unroll
            for (int m = 0; m < 4; ++m) { bf16_t* rowp = O + (size_t)(row0 + ai * HALF + m * 16) * ldc + col0; f32x4 r0, r1; const float rr = rs[row0 + ai * HALF + m * 16];
#pragma unroll
                for (int e = 0; e < 4; ++e) { const float g0 = acc[ai][0][m][0][e] * rr, g1 = acc[ai][0][m][1][e] * rr; r0[e] = g0 * sigm(g0) * (acc[ai][1][m][0][e] * rr); r1[e] = g1 * sigm(g1) * (acc[ai][1][m][1][e] * rr); }
                *(u32x4*)rowp = pack8(r0, r1); }
    }
};
struct EpiYss {
    static constexpr bool PERM = true, AFTER_DRAIN = false; bf16_t* O; float* rowss;
    __device__ __forceinline__ void operator()(const f32x4 (&acc)[2][2][4][2], const Unit& u, int wr, int wc, int fr, int fq) const {
        const int row0 = u.pm * BM + wr * 64 + fr, col0 = u.pn * BM + wc * 32 + 8 * fq;
#pragma unroll
        for (int ai = 0; ai < 2; ++ai)
#pragma unroll
            for (int m = 0; m < 4; ++m) { const int row = row0 + ai * HALF + m * 16; bf16_t* rowp = O + (size_t)row * 1024 + col0; float ss = 0.f;
#pragma unroll
                for (int bj = 0; bj < 2; ++bj) { const f32x4 a = acc[ai][bj][m][0], b = acc[ai][bj][m][1];
                    ss += (a[0] * a[0] + a[1] * a[1]) + (a[2] * a[2] + a[3] * a[3]) + (b[0] * b[0] + b[1] * b[1]) + (b[2] * b[2] + b[3] * b[3]);
                    *(u32x4*)(rowp + bj * HALF) = pack8(a, b); }
                ss += __shfl_xor(ss, 16); ss += __shfl_xor(ss, 32);
                if (fq == 0) rowss[(size_t)row * 16 + u.pn * 4 + wc] = ss; }
    }
};
struct EpiIn {
    static constexpr bool PERM = true, AFTER_DRAIN = false; bf16_t* P; int pitch; float* kp; float* vp; float* ks; float* vs; int mp; const float* rs;
    __device__ __forceinline__ void operator()(const f32x4 (&acc)[2][2][4][2], const Unit& u, int wr, int wc, int fr, int fq) const {
        const int row0 = u.pm * BM + wr * 64 + fr, col0 = u.pn * BM + wc * 32 + 8 * fq;
        const bool kv = (u.pn >= 2 && u.pn < 6); const bool isk = u.pn < 4;
#pragma unroll
        for (int ai = 0; ai < 2; ++ai)
#pragma unroll
            for (int m = 0; m < 4; ++m) { const int row = row0 + ai * HALF + m * 16; bf16_t* rowp = P + (size_t)row * pitch + col0; const float rr = rs[row];
#pragma unroll
                for (int bj = 0; bj < 2; ++bj) { const f32x4 v0 = acc[ai][bj][m][0] * rr, v1 = acc[ai][bj][m][1] * rr; if (col0 + bj * HALF < pitch) *(u32x4*)(rowp + bj * HALF) = pack8(v0, v1);
                    if (kv) { const int cc = col0 + bj * HALF - (isk ? 512 : 1024);
                        float* o = (row < mp) ? ((isk ? kp : vp) + (size_t)row * 512 + cc) : ((isk ? ks : vs) + (size_t)(row - mp) * 512 + cc);
                        *(f32x4*)o = v0; *(f32x4*)(o + 4) = v1; } } }
    }
};
struct EpiGate {
    static constexpr bool PERM = true, AFTER_DRAIN = false; bf16_t* T0; const bf16_t* T1; const float* rs;
    __device__ __forceinline__ void operator()(const f32x4 (&acc)[2][2][4][2], const Unit& u, int wr, int wc, int fr, int fq) const {
        const int row0 = u.pm * BM + wr * 64 + fr, col0 = u.pn * HALF + wc * 32 + 8 * fq;
#pragma unroll
        for (int ai = 0; ai < 2; ++ai)
#pragma unroll
            for (int m = 0; m < 4; ++m) { const size_t off = (size_t)(row0 + ai * HALF + m * 16) * 1024 + col0; const float rr = rs[row0 + ai * HALF + m * 16];
                const u32x4 a = *(const u32x4*)(T0 + off), b = *(const u32x4*)(T1 + off); f32x4 r0, r1;
#pragma unroll
                for (int e = 0; e < 4; ++e) { const unsigned wa0 = a[e >> 1], wb0 = b[e >> 1], wa1 = a[2 + (e >> 1)], wb1 = b[2 + (e >> 1)];
                    const float t00 = (e & 1) ? bfhi(wa0) : bflo(wa0), t10 = (e & 1) ? bfhi(wb0) : bflo(wb0), t01 = (e & 1) ? bfhi(wa1) : bflo(wa1), t11 = (e & 1) ? bfhi(wb1) : bflo(wb1);
                    r0[e] = sigm(acc[ai][0][m][0][e] * rr) * t00 + sigm(acc[ai][1][m][0][e] * rr) * t10;
                    r1[e] = sigm(acc[ai][0][m][1][e] * rr) * t01 + sigm(acc[ai][1][m][1][e] * rr) * t11; }
                *(u32x4*)(T0 + off) = pack8(r0, r1); }
    }
};


struct SplitKOrder { int nslice, G, c;
    __device__ __forceinline__ bool next(int i, Unit& u) const { const int L = i * G + c; if (L >= 8 * nslice) return false; u.pm = (L >> 2) & 1; u.pn = L & 3; u.koff = (L >> 3) * 512; return true; }
    __device__ __forceinline__ void a_ready(const Unit&) const {}
    __device__ __forceinline__ void done(const Unit&) const {}
};
struct EpiPart { static constexpr bool PERM = true, AFTER_DRAIN = false; float* part;
    __device__ __forceinline__ void operator()(const f32x4 (&acc)[2][2][4][2], const Unit& u, int wr, int wc, int fr, int fq) const {
        const int row0 = u.pm * BM + wr * 64 + fr, col0 = u.pn * BM + wc * 32 + 8 * fq; float* base = part + (size_t)(u.koff >> 9) * 512 * 1024;
#pragma unroll
        for (int ai = 0; ai < 2; ++ai)
#pragma unroll
            for (int m = 0; m < 4; ++m) { float* rowp = base + (size_t)(row0 + ai * HALF + m * 16) * 1024 + col0;
#pragma unroll
                for (int bj = 0; bj < 2; ++bj) { *(f32x4*)(rowp + bj * HALF) = acc[ai][bj][m][0]; *(f32x4*)(rowp + bj * HALF + 4) = acc[ai][bj][m][1]; }
                asm volatile("" ::: "memory"); }
    }
};
template <class Epi, class Sched, bool ALIGN_EPI = false, bool SP2 = false>
__device__ __forceinline__ void gemm_phase(PG8_LAS unsigned char* lds, const Gemm g, const Sched& S, const Epi& E, int tid_in) {
    int tid_ = tid_in; asm volatile("" : "+v"(tid_));
    const int tid = tid_, wid = __builtin_amdgcn_readfirstlane(tid >> 6), lane = tid & 63, wr = wid >> 2, wc = wid & 3, fr = lane & 15, fq = lane >> 4;
    const int K = g.K, nt = K / BK;
    unsigned voffA[2], voffB[2];
#pragma unroll
    for (int i = 0; i < 2; ++i) { int R, C; stage_rc(tid * 16 + i * 8192, R, C); const int Rb = Epi::PERM ? ((R & ~31) + perm32(R & 31)) : R;
        voffA[i] = (unsigned)(R * g.lda + C) * 2u; voffB[i] = (unsigned)(Rb * g.ldb + C) * 2u; }
    const size_t kstep = (size_t)(BK * 2);
    const size_t hstepA = (size_t)HALF * g.lda * 2, hstepB = (size_t)HALF * g.ldb * 2;
    const size_t tstepA = 2 * hstepA, tstepB = 2 * hstepB;
    const unsigned ldsw = (unsigned)wid * 1024u;
    const int aoff = lds_byte(wr * 64 + fr, fq * 8), boff = lds_byte(wc * 32 + fr, fq * 8);
#define PG8_SA(b, h) (((b) * 2 + (h)) * HTB)
#define PG8_SB(b, h) ((4 + (b) * 2 + (h)) * HTB)
#define PG8_STAGE(bufoff, gbase, voff) do { _Pragma("unroll") for (int _i = 0; _i < 2; ++_i) \
        __builtin_amdgcn_global_load_lds((const unsigned*)((const char*)(gbase) + (voff)[_i]), (PG8_LAS unsigned*)(lds + (bufoff) + ldsw + _i * 8192), 16, 0, 0); } while (0)
#define PG8_LDA(dst, b, h) do { _Pragma("unroll") for (int m = 0; m < 4; ++m) _Pragma("unroll") for (int k = 0; k < 2; ++k) dst[m][k] = *(const PG8_LAS bf16x8*)(lds + PG8_SA(b, h) + aoff + m * 2048 + k * 1024); } while (0)
#define PG8_LDB(dst, b, h) do { _Pragma("unroll") for (int n = 0; n < 2; ++n) _Pragma("unroll") for (int k = 0; k < 2; ++k) dst[n][k] = *(const PG8_LAS bf16x8*)(lds + PG8_SB(b, h) + boff + n * 2048 + k * 1024); } while (0)
#define PG8_MMA(ai, bj, At, Bt) do { __builtin_amdgcn_s_setprio(1); _Pragma("unroll") for (int m = 0; m < 4; ++m) _Pragma("unroll") for (int n = 0; n < 2; ++n) _Pragma("unroll") for (int k = 0; k < 2; ++k) \
        acc[ai][bj][m][n] = __builtin_amdgcn_mfma_f32_16x16x32_bf16(Bt[n][k], At[m][k], acc[ai][bj][m][n], 0, 0, 0); __builtin_amdgcn_s_setprio(0); } while (0)
#define PG8_WAIT_V(n) asm volatile("s_waitcnt vmcnt(" #n ")" ::: "memory")
#define PG8_WAIT_L(n) asm volatile("s_waitcnt lgkmcnt(" #n ")" ::: "memory")
#define PG8_BAR __builtin_amdgcn_s_barrier()
#define PG8_SCHED __builtin_amdgcn_sched_barrier(0)
    Unit cur, nxt; int ui = 0;
    if (!S.next(0, cur)) return;
    f32x4 acc[2][2][4][2];
#pragma unroll
    for (int a = 0; a < 2; ++a)
#pragma unroll
        for (int b = 0; b < 2; ++b)
#pragma unroll
            for (int m = 0; m < 4; ++m)
#pragma unroll
                for (int n = 0; n < 2; ++n) acc[a][b][m][n] = (f32x4){0.f, 0.f, 0.f, 0.f};
    bf16x8 At[4][2], B0[2][2], B1[2][2];
    const char* cA = (const char*)g.A + (size_t)cur.pm * tstepA + cur.koff; const char* cB = (const char*)g.Bt + (size_t)cur.pn * tstepB + cur.koff;
    S.a_ready(cur);
    if constexpr (SP2) {
        PG8_STAGE(PG8_SB(0, 0), cB, voffB); PG8_STAGE(PG8_SB(0, 1), cB + hstepB, voffB); PG8_STAGE(PG8_SA(0, 0), cA, voffA); PG8_STAGE(PG8_SA(0, 1), cA + hstepA, voffA);
        if (wr == 1) PG8_BAR;
        PG8_WAIT_V(2); PG8_BAR;
        PG8_STAGE(PG8_SB(1, 0), cB + kstep, voffB); PG8_STAGE(PG8_SA(1, 0), cA + kstep, voffA); PG8_STAGE(PG8_SB(1, 1), cB + hstepB + kstep, voffB);
        PG8_WAIT_V(6); PG8_BAR;
    } else {
        PG8_STAGE(PG8_SB(0, 0), cB, voffB); PG8_STAGE(PG8_SA(0, 0), cA, voffA); PG8_STAGE(PG8_SB(0, 1), cB + hstepB, voffB); PG8_STAGE(PG8_SA(0, 1), cA + hstepA, voffA);
        if (wr == 1) PG8_BAR;
        PG8_WAIT_V(4); PG8_BAR;
        PG8_STAGE(PG8_SB(1, 0), cB + kstep, voffB); PG8_STAGE(PG8_SA(1, 0), cA + kstep, voffA); PG8_STAGE(PG8_SB(1, 1), cB + hstepB + kstep, voffB);
        PG8_WAIT_V(6); PG8_BAR;
    }
    for (;;) {
        const bool has_next = S.next(ui + 1, nxt);
        const char* nA = has_next ? (const char*)g.A + (size_t)nxt.pm * tstepA + nxt.koff : cA; const char* nB = has_next ? (const char*)g.Bt + (size_t)nxt.pn * tstepB + nxt.koff : cB;
        for (int t = 0; t < nt; t += 2) {
            const bool last = (t == nt - 2);
            const char* a1 = cA + (size_t)(t + 1) * kstep;
            const char* a2 = last ? nA : cA + (size_t)(t + 2) * kstep; const char* b2 = last ? nB : cB + (size_t)(t + 2) * kstep;
            const char* a3 = a2 + kstep; const char* b3 = b2 + kstep;
            if (last && has_next) S.a_ready(nxt);
            if constexpr (SP2) {
            PG8_LDB(B0, 0, 0); PG8_LDB(B1, 0, 1); PG8_SCHED; PG8_LDA(At, 0, 0); PG8_STAGE(PG8_SA(1, 1), a1 + hstepA, voffA);
            PG8_WAIT_V(8); PG8_WAIT_L(0); PG8_BAR; PG8_MMA(0, 0, At, B0); PG8_MMA(0, 1, At, B1); PG8_BAR; PG8_SCHED;
            PG8_LDA(At, 0, 1); PG8_STAGE(PG8_SB(0, 0), b2, voffB); PG8_STAGE(PG8_SB(0, 1), b2 + hstepB, voffB); PG8_STAGE(PG8_SA(0, 0), a2, voffA);
            PG8_WAIT_V(8); PG8_WAIT_L(0); PG8_BAR; PG8_MMA(1, 0, At, B0); PG8_MMA(1, 1, At, B1); PG8_BAR; PG8_SCHED;
            PG8_LDB(B0, 1, 0); PG8_LDB(B1, 1, 1); PG8_SCHED; PG8_LDA(At, 1, 0); PG8_STAGE(PG8_SA(0, 1), a2 + hstepA, voffA);
            PG8_WAIT_V(8); PG8_WAIT_L(0); PG8_BAR; PG8_MMA(0, 0, At, B0); PG8_MMA(0, 1, At, B1); PG8_BAR; PG8_SCHED;
            PG8_LDA(At, 1, 1); PG8_STAGE(PG8_SB(1, 0), b3, voffB); PG8_STAGE(PG8_SB(1, 1), b3 + hstepB, voffB); PG8_STAGE(PG8_SA(1, 0), a3, voffA);
            PG8_WAIT_V(8); PG8_WAIT_L(0); PG8_BAR; PG8_MMA(1, 0, At, B0); PG8_MMA(1, 1, At, B1); PG8_BAR; PG8_SCHED;
            } else {
            PG8_LDB(B0, 0, 0); PG8_SCHED; PG8_LDA(At, 0, 0); PG8_STAGE(PG8_SA(1, 1), a1 + hstepA, voffA);
            PG8_WAIT_L(8); PG8_BAR; PG8_WAIT_L(0); PG8_MMA(0, 0, At, B0); PG8_BAR; PG8_SCHED;
            PG8_LDB(B1, 0, 1); PG8_STAGE(PG8_SB(0, 0), b2, voffB);
            PG8_BAR; PG8_WAIT_L(0); PG8_MMA(0, 1, At, B1); PG8_BAR;
            PG8_LDA(At, 0, 1); PG8_STAGE(PG8_SA(0, 0), a2, voffA);
            PG8_BAR; PG8_WAIT_L(0); PG8_MMA(1, 0, At, B0); PG8_BAR; PG8_SCHED;
            PG8_STAGE(PG8_SB(0, 1), b2 + hstepB, voffB);
            PG8_WAIT_V(6); PG8_BAR; PG8_MMA(1, 1, At, B1); PG8_BAR;
            PG8_LDB(B0, 1, 0); PG8_SCHED; PG8_LDA(At, 1, 0); PG8_STAGE(PG8_SA(0, 1), a2 + hstepA, voffA);
            PG8_WAIT_L(8); PG8_BAR; PG8_WAIT_L(0); PG8_MMA(0, 0, At, B0); PG8_BAR; PG8_SCHED;
            PG8_LDB(B1, 1, 1); PG8_STAGE(PG8_SB(1, 0), b3, voffB);
            PG8_BAR; PG8_WAIT_L(0); PG8_MMA(0, 1, At, B1); PG8_BAR;
            PG8_LDA(At, 1, 1); PG8_STAGE(PG8_SA(1, 0), a3, voffA);
            PG8_BAR; PG8_WAIT_L(0); PG8_MMA(1, 0, At, B0); PG8_BAR; PG8_SCHED;
            PG8_STAGE(PG8_SB(1, 1), b3 + hstepB, voffB);
            PG8_WAIT_V(6); PG8_BAR; PG8_MMA(1, 1, At, B1); PG8_BAR;
            }
        }
        if constexpr (ALIGN_EPI) { if (wr == 0) PG8_BAR; }
        if constexpr (!Epi::AFTER_DRAIN) { E(acc, cur, wr, wc, fr, fq); S.done(cur); }
        if (!has_next) break;
#pragma unroll
        for (int a = 0; a < 2; ++a)
#pragma unroll
            for (int b = 0; b < 2; ++b)
#pragma unroll
                for (int m = 0; m < 4; ++m)
#pragma unroll
                    for (int n = 0; n < 2; ++n) acc[a][b][m][n] = (f32x4){0.f, 0.f, 0.f, 0.f};
        cur = nxt; cA = nA; cB = nB; ++ui;
        if constexpr (ALIGN_EPI) { if (wr == 1) PG8_BAR; }
    }
    PG8_WAIT_V(0);
    if constexpr (!ALIGN_EPI) { if (wr == 0) PG8_BAR; }
    PG8_BAR;
    if constexpr (Epi::AFTER_DRAIN) { E.fused(acc, cur, wr, wc, fr, fq, lds, wid, lane); S.done(cur); }
#undef PG8_SA
#undef PG8_SB
#undef PG8_STAGE
#undef PG8_LDA
#undef PG8_LDB
#undef PG8_MMA
#undef PG8_WAIT_V
#undef PG8_WAIT_L
#undef PG8_BAR
#undef PG8_SCHED
}
}

#define LAS __attribute__((address_space(3)))
typedef unsigned short bf16;
typedef float f32x4 __attribute__((ext_vector_type(4)));
typedef float f32x16 __attribute__((ext_vector_type(16)));
typedef short bf16x8 __attribute__((ext_vector_type(8)));
typedef short s16x4 __attribute__((ext_vector_type(4)));
typedef unsigned u32x4 __attribute__((ext_vector_type(4)));
typedef unsigned u32x2 __attribute__((ext_vector_type(2)));

constexpr int D = 1024, MP = 32768, MS = 512, M = MP + MS, FF = 2816, NUP = 5632, NINP = 3840, PIN = 3600, NGATE = 2048, SEQ = 8192, PAST = 2048, INDIM = 5640;
constexpr float EPS = 1e-6f, LOG2E = 1.4426950408889634f;
constexpr size_t MiB = 1u << 20;
constexpr size_t WS_CTL = 0, CTL_BYTES = 64 * 1024;
constexpr size_t WS_GC = 1 * MiB, WS_BE = 2 * MiB, WS_RS = 2 * MiB + 768 * 1024;
constexpr size_t WS_W = 3 * MiB;
constexpr size_t W_UP1 = 0, W_DN1 = 11534336, W_IN = 17301504, W_G = 25165824, W_BSB = 29360128, W_BGD = 30408704, W_OUT = 31457280, W_UP2 = 33554432, W_DN2 = 45088768, W_END = 50855936;
constexpr size_t WS_XN = 52 * MiB;
constexpr size_t WS_R1 = 117 * MiB;
constexpr size_t WS_YT = 346 * MiB;
constexpr size_t YT_HALF = (size_t)M * 1024 * 2;
constexpr size_t WS_OR = 476 * MiB;
constexpr size_t WS_ROWSS = 509 * MiB;
constexpr size_t WS_END = WS_ROWSS + (size_t)M * 64;
static_assert(WS_W + W_END <= WS_XN && WS_XN + (size_t)M * 1024 * 2 <= WS_R1 && WS_R1 + (size_t)M * PIN * 2 <= WS_YT && WS_YT + 2 * YT_HALF <= WS_OR && WS_OR + (size_t)M * 512 * 2 <= WS_ROWSS && WS_ROWSS + (size_t)M * 64 <= WS_END, "ws map");
constexpr size_t O_Y = 0, O_KP = (size_t)M * 1024, O_VP = O_KP + 2ull * MP * 512, O_GP = O_VP + 2ull * MP * 512, O_CP = O_GP + 2ull * 4 * 4 * 16384, O_KS = O_CP + 2ull * 4 * 3 * 1536,
                 O_VS = O_KS + 2ull * MS * 512, O_GS = O_VS + 2ull * MS * 512, O_CS = O_GS + 2ull * 8 * 4 * 16384, O_END = O_CS + 2ull * 8 * 3 * 1536;
constexpr int LDS_BYTES = 155648, LDS_Q = LDS_BYTES - 64;
constexpr int NPH = 29;

struct Args { const float* in[19]; float* out; unsigned char* ws; int ph_lo, ph_hi; };
struct Ctx {
    const float *xp, *xs, *cache_k, *cache_v, *state_gdn, *state_conv, *gains, *w1u, *w1d, *win, *convw, *alog, *dtb, *gng, *wbs, *wbg, *wout, *w2u, *w2d;
    float* out; unsigned char* ws; unsigned* ctl; float* rowss; float* gc; float* be; float* rs; bf16* XN; bf16* P; bf16* ACT; unsigned char* YT; bf16* OR;
    int tid, lane, wave, G, bid;
};
#define LDS_WAIT() asm volatile("s_waitcnt lgkmcnt(0)" ::: "memory")
__device__ __forceinline__ void lds_barrier() { asm volatile("s_waitcnt lgkmcnt(0)\n\ts_barrier" ::: "memory"); }
__device__ __forceinline__ unsigned pk2(float lo, float hi) { return pg8::cvt_pk_bf16(lo, hi); }
__device__ __forceinline__ unsigned short f2b(float x) { return (unsigned short)(pk2(x, 0.f) & 0xffffu); }
__device__ __forceinline__ float bflo(unsigned u) { return __uint_as_float(u << 16); }
__device__ __forceinline__ float bfhi(unsigned u) { return __uint_as_float(u & 0xffff0000u); }
__device__ __forceinline__ float b2f(unsigned short u) { return __uint_as_float((unsigned)u << 16); }
__device__ __forceinline__ float sigm(float x) { return pg8::sigm(x); }
__device__ __forceinline__ float wave_sum(float v) {
#pragma unroll
    for (int o = 1; o < 64; o <<= 1) v += __shfl_xor(v, o);
    return v;
}
__device__ __forceinline__ f32x4 mfma16(bf16x8 a, bf16x8 b, f32x4 c) { return __builtin_amdgcn_mfma_f32_16x16x32_bf16(a, b, c, 0, 0, 0); }
__device__ __forceinline__ f32x16 mfma32(bf16x8 a, bf16x8 b, f32x16 c) { return __builtin_amdgcn_mfma_f32_32x32x16_bf16(a, b, c, 0, 0, 0); }

#define XB_TMO      128
#define XB_XCNT(j)  (256  + 64 * (j))
#define XB_XSUB(j)  (1280 + 64 * (j))
#define XB_XGEN(j)  (2304 + 64 * (j))
#define XB_TOP      3328
#define XB_TOPGEN   3392
#define XCD_BAR_WORDS 3456
#define XB_SPIN_CAP (1u << 18)

__device__ __forceinline__ unsigned xb_ld(unsigned* p)              { return __hip_atomic_load(p, __ATOMIC_RELAXED, __HIP_MEMORY_SCOPE_AGENT); }
__device__ __forceinline__ unsigned xb_add(unsigned* p, unsigned v) { return __hip_atomic_fetch_add(p, v, __ATOMIC_RELAXED, __HIP_MEMORY_SCOPE_AGENT); }
__device__ __forceinline__ unsigned xb_xcc_id() { return (unsigned)__builtin_amdgcn_s_getreg((3 << 11) | 20) & 0xFu; }
#define XB_SPIN(cond, bar) do { unsigned _sp = 0; while (cond) { __builtin_amdgcn_s_sleep(1); \
    if ((++_sp & 255u) == 0u) { if (xb_ld(&(bar)[XB_TMO])) break; if (_sp > XB_SPIN_CAP) { atomicAdd(&(bar)[XB_TMO], 1u); break; } } } } while (0)

struct XcdBarrier {
    unsigned* bar; unsigned x;
    volatile LAS unsigned* st;
};

__device__ __forceinline__ XcdBarrier xcd_barrier_post(unsigned* bar, volatile LAS unsigned* st) {
    XcdBarrier b; b.bar = bar; b.x = xb_xcc_id(); b.st = st;
    if (threadIdx.x == 0) (void)xb_add(&bar[XB_XCNT(b.x)], 1u);
    return b;
}
__device__ __forceinline__ void xcd_barrier_complete(unsigned* bar, unsigned x, unsigned& nloc, unsigned& nx) {
    const unsigned G = gridDim.x * gridDim.y * gridDim.z;
    unsigned sum, cnt, mine, sp = 0u;
    for (;;) {
        sum = 0u; cnt = 0u; mine = 0u;
#pragma unroll
        for (unsigned j = 0; j < 16; ++j) { const unsigned c = xb_ld(&bar[XB_XCNT(j)]); sum += c; cnt += (c > 0u) ? 1u : 0u; mine = (j == x) ? c : mine; }
        if (sum == G) break;
        __builtin_amdgcn_s_sleep(1);
        if ((++sp & 255u) == 0u) { if (xb_ld(&bar[XB_TMO])) break; if (sp > XB_SPIN_CAP) { atomicAdd(&bar[XB_TMO], 1u); break; } }
    }
    nloc = mine > 0u ? mine : 1u; nx = cnt > 0u ? cnt : 1u;
}

__device__ __forceinline__ void xcd_barrier(const XcdBarrier& b) {
    asm volatile("s_waitcnt vmcnt(0)" ::: "memory");
    __syncthreads();
    if (threadIdx.x == 0) {
        unsigned* bar = b.bar;
        __builtin_amdgcn_s_waitcnt(0);
        unsigned nloc = b.st[0], nx = b.st[1];
        if (nloc == 0u) { xcd_barrier_complete(bar, b.x, nloc, nx); b.st[0] = nloc; b.st[1] = nx; }
        const unsigned old = xb_add(&bar[XB_XSUB(b.x)], 1u);
        const unsigned gen = old / nloc;
        if (old + 1u == (gen + 1u) * nloc) {
            __builtin_amdgcn_fence(__ATOMIC_RELEASE, "agent");
            asm volatile("s_waitcnt vmcnt(0)" ::: "memory");
            const unsigned og = xb_add(&bar[XB_TOP], 1u);
            const unsigned tg = og / nx;
            if (og + 1u == (tg + 1u) * nx) xb_add(&bar[XB_TOPGEN], 1u);
            else XB_SPIN(xb_ld(&bar[XB_TOPGEN]) == tg, bar);
            __builtin_amdgcn_fence(__ATOMIC_ACQUIRE, "agent");
            xb_add(&bar[XB_XGEN(b.x)], 1u);
            asm volatile("s_waitcnt vmcnt(0)" ::: "memory");
        } else {
            XB_SPIN(xb_ld(&bar[XB_XGEN(b.x)]) == gen, bar);
            __builtin_amdgcn_fence(__ATOMIC_ACQUIRE, "agent");
            asm volatile("s_waitcnt vmcnt(0)" ::: "memory");
        }
    }
    __syncthreads();
}

__device__ __forceinline__ void tr_item(const float* W, int ldw, int src0, int nvalid, int K, bf16* WT, int HW, LAS float* scr, int kb, int nb, int lane, const float* gk = nullptr) {
    const int k0 = 64 * kb, n0 = 32 * nb, c4 = lane & 7, rsub = lane >> 3, nn = n0 + 4 * c4;
    const bool ok = nn < nvalid; const float* src = W + (size_t)(k0 + rsub) * ldw + src0 + nn;
    f32x4 v[8];
#pragma unroll
    for (int i = 0; i < 8; ++i) v[i] = ok ? *(const f32x4*)(src + (size_t)(8 * i) * ldw) : (f32x4){0.f, 0.f, 0.f, 0.f};
#pragma unroll
    for (int i = 0; i < 8; ++i) { const int kk = 8 * i + rsub; const float g = gk ? gk[k0 + kk] : 1.f;
#pragma unroll
        for (int e = 0; e < 4; ++e) scr[kk * 33 + 4 * c4 + e] = v[i][e] * g; }
    LDS_WAIT(); asm volatile("" ::: "memory");
    int drow0 = n0; if (HW) { const int hf = n0 / HW, j = n0 - hf * HW; drow0 = 256 * (j >> 7) + 128 * hf + (j & 127); }
    const int c = lane & 7;
#pragma unroll
    for (int j = 0; j < 4; ++j) { const int n = (lane >> 3) + 8 * j; const LAS float* s = scr + (8 * c) * 33 + n;
        u32x4 o; o.x = pk2(s[0 * 33], s[1 * 33]); o.y = pk2(s[2 * 33], s[3 * 33]); o.z = pk2(s[4 * 33], s[5 * 33]); o.w = pk2(s[6 * 33], s[7 * 33]);
        *(u32x4*)(WT + (size_t)(drow0 + n) * K + k0 + 8 * c) = o; }
    LDS_WAIT(); asm volatile("" ::: "memory");
}
__device__ __forceinline__ void convert_weights(const Ctx& C, int l, LAS unsigned char* lds) {
    LAS float* scr = (LAS float*)(lds + C.wave * 16384);
    const int gw = C.bid * 8 + C.wave, NGW = C.G * 8;
    bf16* Wb = (bf16*)(C.ws + WS_W); const float* gl = C.gains + (size_t)l * 6 * D;
    constexpr int I_UP = 16 * 176, I_DN = 44 * 32, I_IN = 16 * 120, I_G = 16 * 64, I_B = 8 * 32, I_O = 16 * 32;
    constexpr int NITEMS = 2 * I_UP + 2 * I_DN + I_IN + I_G + 2 * I_B + I_O;
    for (int it = gw; it < NITEMS; it += NGW) {
        int r = it;
        if (r < I_UP) { tr_item(C.w1u + (size_t)l * D * NUP, NUP, 0, NUP, D, Wb + W_UP1 / 2, FF, scr, r / 176, r % 176, C.lane, gl + 0 * D); continue; } r -= I_UP;
        if (r < I_UP) { tr_item(C.w2u + (size_t)l * D * NUP, NUP, 0, NUP, D, Wb + W_UP2 / 2, FF, scr, r / 176, r % 176, C.lane, gl + 4 * D); continue; } r -= I_UP;
        if (r < I_DN) { tr_item(C.w1d + (size_t)l * FF * D, D, 0, D, FF, Wb + W_DN1 / 2, 0, scr, r / 32, r % 32, C.lane); continue; } r -= I_DN;
        if (r < I_DN) { tr_item(C.w2d + (size_t)l * FF * D, D, 0, D, FF, Wb + W_DN2 / 2, 0, scr, r / 32, r % 32, C.lane); continue; } r -= I_DN;
        if (r < I_IN) { tr_item(C.win + (size_t)l * D * INDIM, INDIM, 0, 3592, D, Wb + W_IN / 2, 0, scr, r / 120, r % 120, C.lane, gl + 2 * D); continue; } r -= I_IN;
        if (r < I_G) { tr_item(C.win + (size_t)l * D * INDIM, INDIM, 3592, 2048, D, Wb + W_G / 2, 1024, scr, r / 64, r % 64, C.lane, gl + 2 * D); continue; } r -= I_G;
        if (r < I_B) { tr_item(C.wbs + (size_t)l * 512 * D, D, 0, D, 512, Wb + W_BSB / 2, 0, scr, r / 32, r % 32, C.lane); continue; } r -= I_B;
        if (r < I_B) { tr_item(C.wbg + (size_t)l * 512 * D, D, 0, D, 512, Wb + W_BGD / 2, 0, scr, r / 32, r % 32, C.lane); continue; } r -= I_B;
        tr_item(C.wout + (size_t)l * D * D, D, 0, D, D, Wb + W_OUT / 2, 0, scr, r / 32, r % 32, C.lane);
    }
}

struct InitRow { f32x4 v0, v1, v2, v3; };
__device__ __forceinline__ InitRow init_load(const Ctx& C, int r) { const float* src = ((r < MP) ? C.xp + (size_t)r * D : C.xs + (size_t)(r - MP) * D) + 4 * C.lane;
    InitRow t; t.v0 = *(const f32x4*)(src); t.v1 = *(const f32x4*)(src + 256); t.v2 = *(const f32x4*)(src + 512); t.v3 = *(const f32x4*)(src + 768); return t; }
__device__ __forceinline__ void init_finish(const Ctx& C, const InitRow& t, int r) {
    const f32x4 q = t.v0 * t.v0 + t.v1 * t.v1 + t.v2 * t.v2 + t.v3 * t.v3;
    const float rstd = 1.0f / sqrtf(wave_sum((q[0] + q[1]) + (q[2] + q[3])) * (1.f / D) + EPS);
    bf16* xn = C.XN + (size_t)r * D + 4 * C.lane; u32x2 w;
    w.x = pk2(t.v0[0], t.v0[1]); w.y = pk2(t.v0[2], t.v0[3]); *(u32x2*)(xn) = w; w.x = pk2(t.v1[0], t.v1[1]); w.y = pk2(t.v1[2], t.v1[3]); *(u32x2*)(xn + 256) = w;
    w.x = pk2(t.v2[0], t.v2[1]); w.y = pk2(t.v2[2], t.v2[3]); *(u32x2*)(xn + 512) = w; w.x = pk2(t.v3[0], t.v3[1]); w.y = pk2(t.v3[2], t.v3[3]); *(u32x2*)(xn + 768) = w;
    if (C.lane == 0) C.rs[r] = rstd;
}
__device__ __forceinline__ void row_init_phase(const Ctx& C) {
    const int gw = C.bid * 8 + C.wave, NGW = C.G * 8;
#pragma unroll 1
    for (int r0 = gw; r0 < M; r0 += 2 * NGW) { const int r1 = (r0 + NGW < M) ? r0 + NGW : r0;
        const InitRow ta = init_load(C, r0), tb = init_load(C, r1);
        init_finish(C, ta, r0); init_finish(C, tb, r1); }
}
template <int NS> __device__ __forceinline__ void thin_rows(const Ctx& C, const bf16* Y, float scale, const float* gpost, bool final_out, const float* part, int rbeg, int rend, int rstep) {
    f32x4 gp[4];
#pragma unroll
    for (int j = 0; j < 4; ++j) gp[j] = *(const f32x4*)(gpost + 4 * C.lane + 256 * j);
    for (int r = rbeg; r < rend; r += rstep) {
        bf16* xr = C.XN + (size_t)r * D; const bf16* yr = Y + (size_t)r * D;
        f32x4 yv[4]; float ss;
        if (r >= MP) {
            float q = 0.f;
#pragma unroll
            for (int j = 0; j < 4; ++j) { f32x4 pa[NS];
#pragma unroll
                for (int ks = 0; ks < NS; ++ks) pa[ks] = *(const f32x4*)(part + ((size_t)ks * 512 + (r - MP)) * 1024 + 4 * C.lane + 256 * j);
                f32x4 a = pa[0];
#pragma unroll
                for (int ks = 1; ks < NS; ++ks) a += pa[ks];
                yv[j] = a; q += (a[0] * a[0] + a[1] * a[1]) + (a[2] * a[2] + a[3] * a[3]); }
            ss = wave_sum(q);
        } else { float pv = (C.lane < 16) ? C.rowss[(size_t)r * 16 + C.lane] : 0.f;
            pv += __shfl_xor(pv, 8); pv += __shfl_xor(pv, 4); pv += __shfl_xor(pv, 2); pv += __shfl_xor(pv, 1);
            ss = __shfl(pv, 0);
#pragma unroll
            for (int j = 0; j < 4; ++j) { const u32x2 y = *(const u32x2*)(yr + 4 * C.lane + 256 * j); yv[j] = (f32x4){bflo(y.x), bfhi(y.x), bflo(y.y), bfhi(y.y)}; } }
        const float rsy = scale / sqrtf(ss * (1.f / D) + EPS);
        f32x4 v[4]; float s = 0.f;
#pragma unroll
        for (int j = 0; j < 4; ++j) { const u32x2 x = *(const u32x2*)(xr + 4 * C.lane + 256 * j);
            v[j][0] = bflo(x.x) + yv[j][0] * rsy * gp[j][0]; v[j][1] = bfhi(x.x) + yv[j][1] * rsy * gp[j][1]; v[j][2] = bflo(x.y) + yv[j][2] * rsy * gp[j][2]; v[j][3] = bfhi(x.y) + yv[j][3] * rsy * gp[j][3];
            s += (v[j][0] * v[j][0] + v[j][1] * v[j][1]) + (v[j][2] * v[j][2] + v[j][3] * v[j][3]); }
        const float rstd = 1.0f / sqrtf(wave_sum(s) * (1.f / D) + EPS);
        if (C.lane == 0) C.rs[r] = rstd;
        float* xo = C.out + O_Y + (size_t)r * D;
#pragma unroll
        for (int j = 0; j < 4; ++j) { u32x2 w; w.x = pk2(v[j][0], v[j][1]); w.y = pk2(v[j][2], v[j][3]); *(u32x2*)(xr + 4 * C.lane + 256 * j) = w;
            if (final_out) *(f32x4*)(xo + 4 * C.lane + 256 * j) = v[j]; }
    }
}
struct ThinRow { u32x2 x0, x1, x2, x3, y0, y1, y2, y3; float pv; };
__device__ __forceinline__ ThinRow thin_load(const Ctx& C, const bf16* Y, int r) { ThinRow t; const bf16* xr = C.XN + (size_t)r * D + 4 * C.lane; const bf16* yr = Y + (size_t)r * D + 4 * C.lane;
    t.pv = (C.lane < 16) ? C.rowss[(size_t)r * 16 + C.lane] : 0.f;
    t.x0 = *(const u32x2*)(xr); t.x1 = *(const u32x2*)(xr + 256); t.x2 = *(const u32x2*)(xr + 512); t.x3 = *(const u32x2*)(xr + 768);
    t.y0 = *(const u32x2*)(yr); t.y1 = *(const u32x2*)(yr + 256); t.y2 = *(const u32x2*)(yr + 512); t.y3 = *(const u32x2*)(yr + 768); return t; }
__device__ __forceinline__ void thin_finish(const Ctx& C, const ThinRow& t, int r, float scale, const f32x4& g0, const f32x4& g1, const f32x4& g2, const f32x4& g3, bool final_out) {
    float p = t.pv; p += __shfl_xor(p, 8); p += __shfl_xor(p, 4); p += __shfl_xor(p, 2); p += __shfl_xor(p, 1);
    const float rsy = scale / sqrtf(__shfl(p, 0) * (1.f / D) + EPS);
#define TH_ROW(XX, YY, GG) (f32x4){bflo(XX.x) + bflo(YY.x) * rsy * GG[0], bfhi(XX.x) + bfhi(YY.x) * rsy * GG[1], bflo(XX.y) + bflo(YY.y) * rsy * GG[2], bfhi(XX.y) + bfhi(YY.y) * rsy * GG[3]}
    const f32x4 v0 = TH_ROW(t.x0, t.y0, g0), v1 = TH_ROW(t.x1, t.y1, g1), v2 = TH_ROW(t.x2, t.y2, g2), v3 = TH_ROW(t.x3, t.y3, g3);
#undef TH_ROW
    const f32x4 q = v0 * v0 + v1 * v1 + v2 * v2 + v3 * v3;
    const float rstd = 1.0f / sqrtf(wave_sum((q[0] + q[1]) + (q[2] + q[3])) * (1.f / D) + EPS);
    bf16* xr = C.XN + (size_t)r * D + 4 * C.lane; float* xo = C.out + O_Y + (size_t)r * D + 4 * C.lane;
    if (!final_out) { if (C.lane == 0) C.rs[r] = rstd; u32x2 w;     w.x = pk2(v0[0], v0[1]); w.y = pk2(v0[2], v0[3]); *(u32x2*)(xr) = w; w.x = pk2(v1[0], v1[1]); w.y = pk2(v1[2], v1[3]); *(u32x2*)(xr + 256) = w;
      w.x = pk2(v2[0], v2[1]); w.y = pk2(v2[2], v2[3]); *(u32x2*)(xr + 512) = w; w.x = pk2(v3[0], v3[1]); w.y = pk2(v3[2], v3[3]); *(u32x2*)(xr + 768) = w; }
    if (final_out) { *(f32x4*)(xo) = v0; *(f32x4*)(xo + 256) = v1; *(f32x4*)(xo + 512) = v2; *(f32x4*)(xo + 768) = v3; }
}
__device__ __forceinline__ void thin_rows2(const Ctx& C, const bf16* Y, float scale, const float* gpost, bool final_out, int rbeg, int rend, int rstep) {
    const f32x4 g0 = *(const f32x4*)(gpost + 4 * C.lane), g1 = *(const f32x4*)(gpost + 4 * C.lane + 256), g2 = *(const f32x4*)(gpost + 4 * C.lane + 512), g3 = *(const f32x4*)(gpost + 4 * C.lane + 768);
#pragma unroll 1
    for (int r0 = rbeg; r0 < rend; r0 += 2 * rstep) {
        const int r1 = (r0 + rstep < rend) ? r0 + rstep : r0;
        const ThinRow ta = thin_load(C, Y, r0), tb = thin_load(C, Y, r1);
        asm volatile("" ::: "memory");
        thin_finish(C, ta, r0, scale, g0, g1, g2, g3, final_out); thin_finish(C, tb, r1, scale, g0, g1, g2, g3, final_out);
    }
}
template <int NS> __device__ __forceinline__ void thin_phase(const Ctx& C, const bf16* Y, float scale, const float* gpost, bool final_out) {
    thin_rows2(C, Y, scale, gpost, final_out, C.bid * 8 + C.wave, MP, C.G * 8);
    thin_rows<NS>(C, Y, scale, gpost, final_out, (const float*)C.OR, MP + C.bid * 8 + C.wave, M, C.G * 8);
}
__device__ __forceinline__ void gdn_norm_row(const Ctx& C, int r, const u32x4& ov, const u32x4& zv, const f32x4& g0, const f32x4& g1) {
    float o[8], z[8];
#pragma unroll
    for (int e = 0; e < 4; ++e) { o[2 * e] = bflo(ov[e]); o[2 * e + 1] = bfhi(ov[e]); z[2 * e] = bflo(zv[e]); z[2 * e + 1] = bfhi(zv[e]); }
    float ss = 0.f;
#pragma unroll
    for (int e = 0; e < 8; ++e) ss += o[e] * o[e];
    ss += __shfl_xor(ss, 1); ss += __shfl_xor(ss, 2); ss += __shfl_xor(ss, 4); ss += __shfl_xor(ss, 8);
    const float rstd = 1.0f / sqrtf(ss * (1.f / 128.f) + EPS);
    f32x4 r0, r1;
#pragma unroll
    for (int e = 0; e < 4; ++e) { r0[e] = o[e] * rstd * g0[e] * z[e] * sigm(z[e]); r1[e] = o[4 + e] * rstd * g1[e] * z[4 + e] * sigm(z[4 + e]); }
    *(u32x4*)(C.P + (size_t)r * PIN + 3072 + C.lane * 8) = pg8::pack8(r0, r1);
}
__device__ __forceinline__ void gdn_norm_phase(const Ctx& C, int l) {
    const int gw = C.bid * 8 + C.wave, NGW = C.G * 8;
    const float* gain = C.gng + l * 128 + (C.lane & 15) * 8;
    const f32x4 g0 = *(const f32x4*)gain, g1 = *(const f32x4*)(gain + 4);
#pragma unroll 1
    for (int r0 = gw; r0 < M; r0 += 2 * NGW) { const int r1 = (r0 + NGW < M) ? r0 + NGW : r0;
        const u32x4 oa = *(const u32x4*)(C.OR + (size_t)r0 * 512 + C.lane * 8), za = *(const u32x4*)(C.P + (size_t)r0 * PIN + 3072 + C.lane * 8);
        const u32x4 ob = *(const u32x4*)(C.OR + (size_t)r1 * 512 + C.lane * 8), zb = *(const u32x4*)(C.P + (size_t)r1 * PIN + 3072 + C.lane * 8);
        asm volatile("" ::: "memory");
        gdn_norm_row(C, r0, oa, za, g0, g1); gdn_norm_row(C, r1, ob, zb, g0, g1); }
}

constexpr int PRE_U = 0, PRE_QN = 65536, PRE_KN = 82944, PRE_AF = 100352, PRE_RN = 117760, PRE_GC = 118272, PRE_BE = 118528;
__device__ __forceinline__ void gdn_pre_unit(const Ctx& C, int l, int n, int h, unsigned char* lds) {
    int tid_ = C.tid; asm volatile("" : "+v"(tid_));
    const int tid = tid_, lane = tid & 63, wave = __builtin_amdgcn_readfirstlane(tid >> 6);
    float* U = (float*)(lds + PRE_U); bf16* QN = (bf16*)(lds + PRE_QN); bf16* KN = (bf16*)(lds + PRE_KN); float* AF = (float*)(lds + PRE_AF);
    float* RN = (float*)(lds + PRE_RN); float* GC = (float*)(lds + PRE_GC); float* BE = (float*)(lds + PRE_BE);
    const int row0 = n * 64; const bool isS = n >= 512; const int sb = n - 512;
    const bool seq_first = isS ? true : ((n & 127) == 0); const bool seq_last = isS ? true : ((n & 127) == 127);
    unsigned char* rec = C.YT + (size_t)(n * 4 + h) * 65536;
    if (tid < 384) {
        const int cgp = tid % 48, rs = tid / 48, part = cgp >> 4, c8 = (cgp & 15) * 8, cc = part * 512 + h * 128 + c8;
        float w[4][8];
#pragma unroll
        for (int i = 0; i < 4; ++i) { const f32x4 a = *(const f32x4*)(C.convw + (size_t)(l * 4 + i) * 1536 + cc), b = *(const f32x4*)(C.convw + (size_t)(l * 4 + i) * 1536 + cc + 4);
#pragma unroll
            for (int e = 0; e < 4; ++e) { w[i][e] = a[e]; w[i][4 + e] = b[e]; } }
        float win[3][8];
#pragma unroll
        for (int i = 0; i < 3; ++i) { const int rr = 8 * rs - 3 + i;
            if (rr >= 0 || !seq_first) { const u32x4 v = *(const u32x4*)(C.P + (size_t)(row0 + rr) * PIN + 1536 + cc);
#pragma unroll
                for (int e = 0; e < 4; ++e) { win[i][2 * e] = bflo(v[e]); win[i][2 * e + 1] = bfhi(v[e]); } }
            else if (isS) { const float* sc = C.state_conv + ((size_t)(l * 8 + sb) * 3 + (3 + rr)) * 1536 + cc; const f32x4 a = *(const f32x4*)sc, b = *(const f32x4*)(sc + 4);
#pragma unroll
                for (int e = 0; e < 4; ++e) { win[i][e] = a[e]; win[i][4 + e] = b[e]; } }
            else {
#pragma unroll
                for (int e = 0; e < 8; ++e) win[i][e] = 0.f; } }
        u32x4 rowv[8];
#pragma unroll
        for (int rr = 0; rr < 8; ++rr) rowv[rr] = *(const u32x4*)(C.P + (size_t)(row0 + 8 * rs + rr) * PIN + 1536 + cc);
#pragma unroll
        for (int rr = 0; rr < 8; ++rr) { const int r = 8 * rs + rr; const u32x4 v = rowv[rr];
            float cur[8], y[8];
#pragma unroll
            for (int e = 0; e < 4; ++e) { cur[2 * e] = bflo(v[e]); cur[2 * e + 1] = bfhi(v[e]); }
#pragma unroll
            for (int e = 0; e < 8; ++e) { const float t = win[0][e] * w[0][e] + win[1][e] * w[1][e] + win[2][e] * w[2][e] + cur[e] * w[3][e]; y[e] = t * sigm(t);
                win[0][e] = win[1][e]; win[1][e] = win[2][e]; win[2][e] = cur[e]; }
            if (part < 2) { *(f32x4*)(U + r * 256 + part * 128 + c8) = (f32x4){y[0], y[1], y[2], y[3]}; *(f32x4*)(U + r * 256 + part * 128 + c8 + 4) = (f32x4){y[4], y[5], y[6], y[7]}; }
            else { u32x4 o; o.x = pk2(y[0], y[1]); o.y = pk2(y[2], y[3]); o.z = pk2(y[4], y[5]); o.w = pk2(y[6], y[7]); *(u32x4*)(rec + 32768 + (size_t)(r * 128 + c8) * 2) = o; }
            if (seq_last && r >= 61) { float* o = C.out + (isS ? O_CS + ((size_t)(l * 8 + sb) * 3 + (r - 61)) * 1536 : O_CP + ((size_t)(l * 4 + (n >> 7)) * 3 + (r - 61)) * 1536) + cc;
                *(f32x4*)o = (f32x4){cur[0], cur[1], cur[2], cur[3]}; *(f32x4*)(o + 4) = (f32x4){cur[4], cur[5], cur[6], cur[7]}; }
        }
    } else if (wave == 7) {
        const float bl = b2f(C.P[(size_t)(row0 + lane) * PIN + 3584 + h]), al = b2f(C.P[(size_t)(row0 + lane) * PIN + 3588 + h]);
        const float beta = sigm(bl); const float xa = al + C.dtb[l * 4 + h];
        const float sp = fmaxf(xa, 0.f) + log1pf(expf(-fabsf(xa)));
        float g = -expf(C.alog[l * 4 + h]) * sp;
#pragma unroll
        for (int o = 1; o < 64; o <<= 1) { const float t = __shfl_up(g, o); if (lane >= o) g += t; }
        GC[lane] = g; BE[lane] = beta; C.gc[(size_t)(n * 4 + h) * 64 + lane] = g; C.be[(size_t)(n * 4 + h) * 64 + lane] = beta;
    }
    lds_barrier();
    { const int r = tid >> 3, sub = tid & 7, part = sub >> 2, qt = sub & 3; const float* u = U + r * 256 + part * 128 + 32 * qt; f32x4 v[8]; float ss = 0.f;
#pragma unroll
        for (int i = 0; i < 8; ++i) { v[i] = *(const f32x4*)(u + 4 * i); ss += (v[i][0] * v[i][0] + v[i][1] * v[i][1]) + (v[i][2] * v[i][2] + v[i][3] * v[i][3]); }
        ss += __shfl_xor(ss, 1); ss += __shfl_xor(ss, 2);
        float rn = 1.0f / sqrtf(ss + EPS); if (part == 0) rn *= 0.08838834764831845f;
        bf16* dl = (part ? KN : QN) + r * 136 + 32 * qt; unsigned char* dg = rec + (part ? 16384 : 0) + (size_t)(r * 128 + 32 * qt) * 2;
#pragma unroll
        for (int i = 0; i < 4; ++i) { const u32x4 o = pg8::pack8(v[2 * i] * rn, v[2 * i + 1] * rn); *(u32x4*)(dl + 8 * i) = o; *(u32x4*)(dg + 16 * i) = o; } }
    lds_barrier();
    { const int p = wave >> 2, mt = wave & 3, lc = lane & 15, lq = lane >> 4; const bf16* Ab = (p ? QN : KN) + (16 * mt + lc) * 136 + 8 * lq;
        bf16x8 af[4];
#pragma unroll
        for (int ks = 0; ks < 4; ++ks) af[ks] = *(const bf16x8*)(Ab + 32 * ks);
#pragma unroll
        for (int nt = 0; nt < 4; ++nt) { f32x4 acc = {0.f, 0.f, 0.f, 0.f};
            if (nt <= mt) {
#pragma unroll
                for (int ks = 0; ks < 4; ++ks) acc = mfma16(af[ks], *(const bf16x8*)(KN + (16 * nt + lc) * 136 + 32 * ks + 8 * lq), acc); }
            const int j = 16 * nt + lc; const float gj = GC[j];
#pragma unroll
            for (int rg = 0; rg < 4; ++rg) { const int i = 16 * mt + 4 * lq + rg; const float dec = (i >= j) ? __expf(GC[i] - gj) : 0.f;
                if (p == 0) AF[i * 68 + j] = (i > j) ? BE[i] * acc[rg] * dec : 0.f;
                else *(bf16*)(rec + 57344 + (size_t)(i * 64 + j) * 2) = f2b((i >= j) ? acc[rg] * dec : 0.f); } } }
    lds_barrier();
    { float* XF = U; float* TP = U + 5120 + wave * 272;
      const int lc = lane & 15, lq = lane >> 4;
      if (wave == 0) {
          const float* ab = AF + (16 * lq) * 68 + 16 * lq; float x[16];
#pragma unroll
          for (int i = 0; i < 16; ++i) { float sv = (i == lc) ? 1.f : 0.f;
#pragma unroll
              for (int j = 0; j < i; ++j) sv -= ab[i * 68 + j] * x[j];
              x[i] = sv; XF[(16 * lq + i) * 68 + 16 * lq + lc] = sv; asm volatile("" ::: "memory"); }
      } else {
          for (int e = tid - 64; e < 6 * 256; e += 448) { const int bk = e >> 8, w = e & 255; const int bi = (bk < 3) ? 0 : (bk < 5 ? 1 : 2), bj = (bk < 3) ? bk + 1 : (bk < 5 ? bk - 1 : 3);
              XF[(16 * bi + (w >> 4)) * 68 + 16 * bj + (w & 15)] = 0.f; } }
      lds_barrier();
#pragma unroll
      for (int lev = 1; lev < 4; ++lev) {
          if (wave < 4 - lev) { const int bi = wave + lev, bj = wave; f32x4 p = {0.f, 0.f, 0.f, 0.f};
              for (int k = bj; k < bi; ++k) {
#pragma unroll
                  for (int ks = 0; ks < 4; ++ks) p = __builtin_amdgcn_mfma_f32_16x16x4f32(AF[(16 * bi + lc) * 68 + 16 * k + 4 * ks + lq], XF[(16 * k + 4 * ks + lq) * 68 + 16 * bj + lc], p, 0, 0, 0); }
#pragma unroll
              for (int rg = 0; rg < 4; ++rg) TP[(4 * lq + rg) * 17 + lc] = p[rg];
              f32x4 x = {0.f, 0.f, 0.f, 0.f};
#pragma unroll
              for (int ks = 0; ks < 4; ++ks) x = __builtin_amdgcn_mfma_f32_16x16x4f32(XF[(16 * bi + lc) * 68 + 16 * bi + 4 * ks + lq], TP[(4 * ks + lq) * 17 + lc], x, 0, 0, 0);
#pragma unroll
              for (int rg = 0; rg < 4; ++rg) XF[(16 * bi + 4 * lq + rg) * 68 + 16 * bj + lc] = -x[rg]; }
          lds_barrier();
      }
      { const int r = tid >> 3, c8 = (tid & 7) * 8; const f32x4 a = *(const f32x4*)(XF + r * 68 + c8), b = *(const f32x4*)(XF + r * 68 + c8 + 4);
        *(u32x4*)(rec + 49152 + (size_t)(r * 64 + c8) * 2) = pg8::pack8(a, b); }
    }
    lds_barrier();
}

constexpr int SC_SET = 58880, SC_KN = 0, SC_QN = 17408, SC_TI = 34816, SC_QK = 44032, SC_VSL = 53248  , SC_GB = 58368  , SC_ST = 2 * SC_SET, SC_STSZ = 8192, SC_DT = SC_ST + 2 * SC_STSZ, SC_VN = SC_DT + 4096, SC_VS = SC_VN + 4096;
static_assert(SC_VS + 4096 <= LDS_Q, "scan LDS");
__device__ __forceinline__ void sc_load(const Ctx& C, int n, int h, int tid, int dv0, u32x4 (&pf)[8]) {
    const unsigned char* rec_ = C.YT + (size_t)(n * 4 + h) * 65536;
    pf[0] = *(const u32x4*)(rec_ + 16384 + (size_t)tid * 16); pf[1] = *(const u32x4*)(rec_ + 16384 + (size_t)(tid + 512) * 16);
    pf[2] = *(const u32x4*)(rec_ + (size_t)tid * 16); pf[3] = *(const u32x4*)(rec_ + (size_t)(tid + 512) * 16);
    pf[4] = *(const u32x4*)(rec_ + 49152 + (size_t)tid * 16); pf[5] = *(const u32x4*)(rec_ + 57344 + (size_t)tid * 16);
    { const int p = tid & 255; pf[6] = *(const u32x4*)(rec_ + 32768 + (size_t)((p >> 2) * 128 + dv0 + 8 * (p & 3)) * 2); }
    { const int q = tid & 31; pf[7] = *(const u32x4*)((q < 16 ? C.gc : C.be) + (size_t)(n * 4 + h) * 64 + (q & 15) * 4); }
}
__device__ __forceinline__ void sc_store(unsigned char* s_, int tid, const u32x4 (&pf)[8]) {
    *(u32x4*)(s_ + SC_KN + (tid >> 4) * 272 + (tid & 15) * 16) = pf[0]; *(u32x4*)(s_ + SC_KN + (32 + (tid >> 4)) * 272 + (tid & 15) * 16) = pf[1];
    *(u32x4*)(s_ + SC_QN + (tid >> 4) * 272 + (tid & 15) * 16) = pf[2]; *(u32x4*)(s_ + SC_QN + (32 + (tid >> 4)) * 272 + (tid & 15) * 16) = pf[3];
    *(u32x4*)(s_ + SC_TI + (tid >> 3) * 144 + (tid & 7) * 16) = pf[4]; *(u32x4*)(s_ + SC_QK + (tid >> 3) * 144 + (tid & 7) * 16) = pf[5];
    if (tid < 256) *(u32x4*)(s_ + SC_VSL + (tid >> 2) * 80 + (tid & 3) * 16) = pf[6];
    if (tid < 32) *(u32x4*)(s_ + SC_GB + tid * 16) = pf[7];
}
typedef short v4i16_t __attribute__((ext_vector_type(4)));
__device__ __forceinline__ s16x4 vtr(const LAS unsigned char* p) { return __builtin_bit_cast(s16x4, __builtin_amdgcn_ds_read_tr16_b64_v4i16((LAS v4i16_t*)p)); }
__device__ __forceinline__ bf16x8 tr_frag(const LAS unsigned char* img, int rowb, int krow0, int col0, int lane) {
    const int g = lane >> 4, q = (lane & 15) >> 2, p = lane & 3;
    const LAS unsigned char* a = img + (krow0 + 8 * g + q) * rowb + (col0 + 4 * p) * 2;
    const s16x4 t0 = vtr(a), t1 = vtr(a + 4 * rowb);
    return (bf16x8){t0[0], t0[1], t0[2], t0[3], t1[0], t1[1], t1[2], t1[3]};
}
__device__ __forceinline__ void sc_step(const Ctx& C, unsigned char* lds, int cur, int n, int h, int dv0, int lane, int mt, int nt, f32x4 (&S)[2]) {
    const int lc = lane & 15, lq = lane >> 4, row0 = n * 64, i = 16 * nt + lc;
    const unsigned char* set = lds + cur * SC_SET; const LAS unsigned char* l3 = (const LAS unsigned char*)lds;
    const LAS unsigned char* STc = l3 + SC_ST + cur * SC_STSZ; unsigned char* STn = lds + SC_ST + (cur ^ 1) * SC_STSZ;
    const float* GB = (const float*)(set + SC_GB); const float gi = GB[i], bi = GB[64 + i], gl = GB[63]; const u32x2 vv = *(const u32x2*)(set + SC_VSL + i * 80 + (16 * mt + 4 * lq) * 2);
    const float eg = __expf(gi), ek = __expf(gl - gi), cd = __expf(gl);
    bf16x8 sa[4]; f32x4 acc = {0.f, 0.f, 0.f, 0.f};
#pragma unroll
    for (int ks = 0; ks < 4; ++ks) { sa[ks] = tr_frag(STc, 64, 32 * ks, 16 * mt, lane);
        acc = mfma16(sa[ks], *(const bf16x8*)(set + SC_KN + (16 * nt + lc) * 272 + (32 * ks + 8 * lq) * 2), acc); }
    { const float v0 = bflo(vv.x), v1 = bfhi(vv.x), v2 = bflo(vv.y), v3 = bfhi(vv.y);
        u32x2 d; d.x = pk2(bi * (v0 - acc[0] * eg), bi * (v1 - acc[1] * eg)); d.y = pk2(bi * (v2 - acc[2] * eg), bi * (v3 - acc[3] * eg));
        *(u32x2*)(lds + SC_DT + i * 64 + (16 * mt + 4 * lq) * 2) = d; }
    lds_barrier();
    f32x4 vn = {0.f, 0.f, 0.f, 0.f};
#pragma unroll
    for (int ks = 0; ks < 2; ++ks) vn = mfma16(tr_frag(l3 + SC_DT, 64, 32 * ks, 16 * mt, lane), *(const bf16x8*)(set + SC_TI + (16 * nt + lc) * 144 + (32 * ks + 8 * lq) * 2), vn);
    { u32x2 a, b; a.x = pk2(vn[0], vn[1]); a.y = pk2(vn[2], vn[3]); b.x = pk2(vn[0] * ek, vn[1] * ek); b.y = pk2(vn[2] * ek, vn[3] * ek);
        *(u32x2*)(lds + SC_VN + i * 64 + (16 * mt + 4 * lq) * 2) = a; *(u32x2*)(lds + SC_VS + i * 64 + (16 * mt + 4 * lq) * 2) = b; }
    lds_barrier();
    { bf16x8 va[2];
#pragma unroll
        for (int ks = 0; ks < 2; ++ks) va[ks] = tr_frag(l3 + SC_VS, 64, 32 * ks, 16 * mt, lane);
#pragma unroll
        for (int t = 0; t < 2; ++t) { const int dkt = 2 * nt + t; S[t] = S[t] * cd;
#pragma unroll
            for (int ks = 0; ks < 2; ++ks) S[t] = mfma16(va[ks], tr_frag(l3 + cur * SC_SET + SC_KN, 272, 32 * ks, 16 * dkt, lane), S[t]);
            u32x2 w; w.x = pk2(S[t][0], S[t][1]); w.y = pk2(S[t][2], S[t][3]);
            *(u32x2*)(STn + (16 * dkt + lc) * 64 + (16 * mt + 4 * lq) * 2) = w; } }
    { f32x4 a1 = {0.f, 0.f, 0.f, 0.f}, a2 = {0.f, 0.f, 0.f, 0.f};
#pragma unroll
        for (int ks = 0; ks < 4; ++ks) a1 = mfma16(sa[ks], *(const bf16x8*)(set + SC_QN + (16 * nt + lc) * 272 + (32 * ks + 8 * lq) * 2), a1);
#pragma unroll
        for (int ks = 0; ks < 2; ++ks) a2 = mfma16(tr_frag(l3 + SC_VN, 64, 32 * ks, 16 * mt, lane), *(const bf16x8*)(set + SC_QK + (16 * nt + lc) * 144 + (32 * ks + 8 * lq) * 2), a2);
        u32x2 o; o.x = pk2(a1[0] * eg + a2[0], a1[1] * eg + a2[1]); o.y = pk2(a1[2] * eg + a2[2], a1[3] * eg + a2[3]);
        *(u32x2*)(C.OR + (size_t)(row0 + i) * 512 + h * 128 + dv0 + 16 * mt + 4 * lq) = o; }
}
__device__ __forceinline__ void scan_unit(const Ctx& C, int l, int isS, int b, int h, int sl, unsigned char* lds, const XcdBarrier* xb) {
    const int tid = C.tid, lane = C.lane, wave = C.wave, lc = lane & 15, lq = lane >> 4, mt = wave & 1, nt = wave >> 1;
    const int nch = isS ? 1 : 128, n0 = isS ? 512 + b : 128 * b, dv0 = 32 * sl;
    f32x4 S[2];
#pragma unroll
    for (int t = 0; t < 2; ++t) { const int dk = 16 * (2 * nt + t) + lc;
        S[t] = isS ? *(const f32x4*)(C.state_gdn + ((size_t)((l * 8 + b) * 4 + h) * 128 + dk) * 128 + dv0 + 16 * mt + 4 * lq) : (f32x4){0.f, 0.f, 0.f, 0.f};
        { u32x2 w; w.x = pk2(S[t][0], S[t][1]); w.y = pk2(S[t][2], S[t][3]); *(u32x2*)(lds + SC_ST + (16 * (2 * nt + t) + lc) * 64 + (16 * mt + 4 * lq) * 2) = w; } }
    u32x4 pfA[8], pfB[8];
    sc_load(C, n0, h, tid, dv0, pfA); sc_store(lds, tid, pfA);
    if (nch == 1) {
        lds_barrier();
        sc_step(C, lds, 0, n0, h, dv0, lane, mt, nt, S);
        lds_barrier();
    } else {
#pragma unroll 1
        for (int half = 0; half < 4; ++half) { const int cb = 32 * half, nlast = n0 + cb + 31;
            if (half) { xcd_barrier(*xb); sc_load(C, n0 + cb, h, tid, dv0, pfA); sc_store(lds, tid, pfA); }
            sc_load(C, n0 + cb + 1, h, tid, dv0, pfB);
            lds_barrier();
            for (int c = cb; c < cb + 32; c += 2) {
                sc_load(C, min(n0 + c + 2, nlast), h, tid, dv0, pfA);
                sc_step(C, lds, 0, n0 + c, h, dv0, lane, mt, nt, S);
                sc_store(lds + SC_SET, tid, pfB);
                lds_barrier();
                sc_load(C, min(n0 + c + 3, nlast), h, tid, dv0, pfB);
                sc_step(C, lds, 1, n0 + c + 1, h, dv0, lane, mt, nt, S);
                sc_store(lds, tid, pfA);
                lds_barrier();
            }
        }
    }
    float* so = C.out + (isS ? O_GS + (size_t)((l * 8 + b) * 4 + h) * 16384 : O_GP + (size_t)((l * 4 + b) * 4 + h) * 16384);
#pragma unroll
    for (int t = 0; t < 2; ++t) *(f32x4*)(so + (size_t)(16 * (2 * nt + t) + lc) * 128 + dv0 + 16 * mt + 4 * lq) = S[t];
}

constexpr int AT_K = 0, AT_V = 8192, AT_FL = 16384;
__device__ __forceinline__ int crow(int r, int hi) { return (r & 3) + 8 * (r >> 2) + 4 * hi; }
__device__ __forceinline__ void sb_block(f32x16& p, int keybase, int qp, bool mask, float& carry, int hi) {
    float G[4];
#pragma unroll
    for (int g = 0; g < 4; ++g) { float kp[4], be[4];
#pragma unroll
        for (int e = 0; e < 4; ++e) { const float z = p[4 * g + e]; const float ex = __builtin_amdgcn_exp2f(-fabsf(z) * (0.125f * LOG2E)); const float r = __builtin_amdgcn_rcpf(1.f + ex); const float er = ex * r;
            const bool pos = z >= 0.f; float bt = pos ? r : er, kv = pos ? er : r;
            if (mask) { const int key = keybase + 8 * g + 4 * hi + e; if (key >= qp) { bt = 0.f; kv = 1.f; } }
            kp[e] = kv; be[e] = bt; }
        const float s2 = kp[3], s1 = kp[3] * kp[2], s0 = s1 * kp[1]; G[g] = s0 * kp[0];
        p[4 * g + 3] = be[3]; p[4 * g + 2] = be[2] * s2; p[4 * g + 1] = be[1] * s1; p[4 * g] = be[0] * s0; }
    float run = carry;
#pragma unroll
    for (int g = 3; g >= 0; --g) { const auto sw = __builtin_amdgcn_permlane32_swap(__float_as_uint(G[g]), __float_as_uint(G[g]), false, false);
        const float gp = __uint_as_float(hi ? sw[0] : sw[1]); const float aft = hi ? run : run * gp;
#pragma unroll
        for (int e = 0; e < 4; ++e) p[4 * g + e] *= aft;
        run *= G[g] * gp; }
    carry = run;
}
__device__ __forceinline__ void attn_unit(const Ctx& C, int l, int isS, int b, int h, int qb, unsigned char* lds) {
    const int tid = C.tid, lane = C.lane, wid = C.wave, r32 = lane & 31, hi = lane >> 5;
    bf16* P = C.P;
    const int q_row0 = isS ? MP + 64 * b : b * SEQ + 256 * qb, qpos0 = isS ? PAST : 256 * qb, nq = isS ? 64 : 256;
    const int kv_pos0 = isS ? PAST : 0, kv_row0 = isS ? MP + 64 * b : b * SEQ;
    const float* Kc = C.cache_k + (size_t)(l * 8 + b) * PAST * 512 + h * 64; const float* Vc = C.cache_v + (size_t)(l * 8 + b) * PAST * 512 + h * 64;
    const int T_top = (qpos0 + nq - 2) >> 6; const bool wact = 32 * wid < nq; const int wtop = (qpos0 + 32 * wid + 30) >> 6;
    bf16x8 qr[4];
#pragma unroll
    for (int d0 = 0; d0 < 4; ++d0) qr[d0] = wact ? *(const bf16x8*)(P + (size_t)(q_row0 + 32 * wid + r32) * PIN + h * 64 + d0 * 16 + hi * 8) : (bf16x8){0, 0, 0, 0, 0, 0, 0, 0};
    f32x16 o[2]; o[0] = f32x16{}; o[1] = f32x16{};
    float carry = 1.f; bool wdone = false;
    u32x4 kreg, vreg;
#define AT_LOAD(t_) do { const int pos0_ = 64 * (t_); \
        if (pos0_ >= kv_pos0) { kreg = *(const u32x4*)(P + (size_t)(kv_row0 + pos0_ - kv_pos0 + lane) * PIN + 512 + h * 64 + wid * 8); \
                                vreg = *(const u32x4*)(P + (size_t)(kv_row0 + pos0_ - kv_pos0 + (tid >> 3)) * PIN + 1024 + h * 64 + (tid & 7) * 8); } \
        else { const float* kp_ = Kc + (size_t)(pos0_ + lane) * 512 + wid * 8; kreg = pg8::pack8(*(const f32x4*)kp_, *(const f32x4*)(kp_ + 4)); \
               const float* vp_ = Vc + (size_t)(pos0_ + (tid >> 3)) * 512 + (tid & 7) * 8; vreg = pg8::pack8(*(const f32x4*)vp_, *(const f32x4*)(vp_ + 4)); } } while (0)
    AT_LOAD(T_top);
    const LAS unsigned char* l3 = (const LAS unsigned char*)lds;
    const int voff = ((lane >> 4) & 1) * 32 + (lane & 3) * 8 + (4 * hi + ((lane & 15) >> 2)) * 64;
    float* fl = (float*)(lds + AT_FL);
    for (int t = T_top; t >= 0; --t) {
        *(u32x4*)(lds + AT_K + wid * 1024 + lane * 16) = kreg;
        *(u32x4*)(lds + AT_V + ((tid & 7) >> 2) * 4096 + (tid >> 3) * 64 + (tid & 3) * 16) = vreg;
        lds_barrier();
        if (t > 0) AT_LOAD(t - 1);
        if (wact && t <= wtop && !wdone) {
            f32x16 p0 = f32x16{}, p1 = f32x16{};
#pragma unroll
            for (int d0 = 0; d0 < 4; ++d0) { const bf16x8 k0 = *(const bf16x8*)(lds + AT_K + (2 * d0 + hi) * 1024 + r32 * 16), k1 = *(const bf16x8*)(lds + AT_K + (2 * d0 + hi) * 1024 + r32 * 16 + 512);
                p0 = mfma32(k0, qr[d0], p0); p1 = mfma32(k1, qr[d0], p1); }
            const int qp = qpos0 + 32 * wid + r32; const bool mask = (64 * t + 63 >= qpos0 + 32 * wid);
            sb_block(p1, 64 * t + 32, qp, mask, carry, hi);
            sb_block(p0, 64 * t, qp, mask, carry, hi);
            bf16x8 pw[4];
            { u32x4 w; w.x = pk2(p0[0], p0[1]); w.y = pk2(p0[2], p0[3]); w.z = pk2(p0[4], p0[5]); w.w = pk2(p0[6], p0[7]); pw[0] = __builtin_bit_cast(bf16x8, w);
              w.x = pk2(p0[8], p0[9]); w.y = pk2(p0[10], p0[11]); w.z = pk2(p0[12], p0[13]); w.w = pk2(p0[14], p0[15]); pw[1] = __builtin_bit_cast(bf16x8, w);
              w.x = pk2(p1[0], p1[1]); w.y = pk2(p1[2], p1[3]); w.z = pk2(p1[4], p1[5]); w.w = pk2(p1[6], p1[7]); pw[2] = __builtin_bit_cast(bf16x8, w);
              w.x = pk2(p1[8], p1[9]); w.y = pk2(p1[10], p1[11]); w.z = pk2(p1[12], p1[13]); w.w = pk2(p1[14], p1[15]); pw[3] = __builtin_bit_cast(bf16x8, w); }
#pragma unroll
            for (int d0 = 0; d0 < 2; ++d0)
#pragma unroll
                for (int s = 0; s < 4; ++s) { const s16x4 a = vtr(l3 + AT_V + d0 * 4096 + s * 1024 + voff), c2 = vtr(l3 + AT_V + d0 * 4096 + s * 1024 + 512 + voff);
                    const bf16x8 vf = (bf16x8){a[0], a[1], a[2], a[3], c2[0], c2[1], c2[2], c2[3]};
                    o[d0] = mfma32(pw[s], vf, o[d0]); }
        }
        { const bool alive = wact && __builtin_amdgcn_ballot_w64(carry >= 1e-30f) != 0ull;
          wdone = !alive;
          if (lane == 0) fl[wid] = alive ? 1.f : 0.f; }
        lds_barrier();
        float mx = 0.f;
#pragma unroll
        for (int w = 0; w < 8; ++w) mx = fmaxf(mx, fl[w]);
        if (mx == 0.f) break;
    }
#undef AT_LOAD
    if (wact) {
#pragma unroll
        for (int d0 = 0; d0 < 2; ++d0)
#pragma unroll
            for (int r = 0; r < 16; ++r) P[(size_t)(q_row0 + 32 * wid + crow(r, hi)) * PIN + h * 64 + 32 * d0 + r32] = f2b(o[d0][r]);
    }
    lds_barrier();
}

#ifndef PHMASK
#define PHMASK 0xffff
#endif
#define HAS(k) (((PHMASK) >> (k)) & 1)
#ifndef PROBE_SEL
#define PROBE_SEL 0
#endif
#define MKCTX Ctx C; C.xp = ap->in[0]; C.xs = ap->in[1]; C.cache_k = ap->in[2]; C.cache_v = ap->in[3]; C.state_gdn = ap->in[4]; C.state_conv = ap->in[5]; C.gains = ap->in[6]; C.w1u = ap->in[7]; C.w1d = ap->in[8]; C.win = ap->in[9]; C.convw = ap->in[10]; C.alog = ap->in[11]; C.dtb = ap->in[12]; C.gng = ap->in[13]; C.wbs = ap->in[14]; C.wbg = ap->in[15]; C.wout = ap->in[16]; C.w2u = ap->in[17]; C.w2d = ap->in[18]; C.out = out_; C.ws = ws_; C.ctl = (unsigned*)(ws_ + WS_CTL); C.rowss = (float*)(ws_ + WS_ROWSS); C.gc = (float*)(ws_ + WS_GC); C.be = (float*)(ws_ + WS_BE); C.rs = (float*)(ws_ + WS_RS); C.XN = (bf16*)(ws_ + WS_XN); C.P = (bf16*)(ws_ + WS_R1); C.ACT = (bf16*)(ws_ + WS_R1); C.YT = ws_ + WS_YT; C.OR = (bf16*)(ws_ + WS_OR); C.tid = tid_; C.lane = C.tid & 63; C.wave = __builtin_amdgcn_readfirstlane(C.tid >> 6); C.G = gridDim.x; C.bid = bid_; LAS unsigned char* lds3 = (LAS unsigned char*)lds; bf16* Wb = (bf16*)(ws_ + WS_W); bf16* Y0 = (bf16*)C.YT; bf16* Y1 = (bf16*)(C.YT + YT_HALF);
template <int ph> __device__ __forceinline__ unsigned long long run_phase(unsigned char* lds, const XcdBarrier& xbar, int wv) {
    unsigned long long tsel = 0ull;
    constexpr int l = (ph - 1) / 14, q = (ph - 1) % 14;
    const __attribute__((address_space(4))) Args* ap = (const __attribute__((address_space(4))) Args*)__builtin_amdgcn_kernarg_segment_ptr();
    int tid_ = wv * 64 + (int)__builtin_amdgcn_mbcnt_hi(~0u, __builtin_amdgcn_mbcnt_lo(~0u, 0u)); int bid_ = blockIdx.x;
    asm volatile("" : "+s"(ap), "+v"(tid_), "+s"(bid_));
    unsigned char* ws_ = ap->ws; float* out_ = ap->out;
    LAS unsigned char* lds3 = (LAS unsigned char*)lds;
    bf16* Wb = (bf16*)(ws_ + WS_W); bf16* Y0 = (bf16*)(ws_ + WS_YT); bf16* Y1 = (bf16*)(ws_ + WS_YT + YT_HALF);
        if constexpr (HAS(0) && ph == 0) { MKCTX; convert_weights(C, 0, lds3); row_init_phase(C); }
        else if constexpr (HAS(1) && (q == 0 || q == 11)) { MKCTX;
            pg8::Gemm g{C.XN, Wb + (q == 0 ? W_UP1 : W_UP2) / 2, M, NUP, D, D, D}; pg8::StaticOrder S; S.init(M, NUP, C.G, C.bid);
            pg8::EpiSwiglu E{C.ACT, FF, C.rs}; pg8::gemm_phase<pg8::EpiSwiglu, pg8::StaticOrder, true, true>(lds3, g, S, E, C.tid);
        } else if constexpr (HAS(2) && (q == 1 || q == 12 || q == 9)) { MKCTX;
            const bf16* A = (q == 9) ? Y0 : C.ACT; const int K = (q == 9) ? D : FF; bf16* O = (q == 9) ? Y1 : Y0; const bf16* W = Wb + (q == 1 ? W_DN1 : q == 12 ? W_DN2 : W_OUT) / 2;
            { pg8::Gemm g{A, W, MP, D, K, K, K}; pg8::StaticOrder S; S.init(MP, D, C.G, C.bid);
              pg8::EpiYss E{O, C.rowss}; pg8::gemm_phase<pg8::EpiYss, pg8::StaticOrder, true, true>(lds3, g, S, E, C.tid); }
        } else if constexpr (HAS(3) && q == 2) { MKCTX; const float* gl = C.gains + (size_t)l * 6 * D; thin_phase<FF / 256>(C, Y0, 0.5f, gl + 1 * D, false); }
        else if constexpr (HAS(3) && q == 10) { MKCTX; const float* gl = C.gains + (size_t)l * 6 * D; thin_phase<D / 256>(C, Y1, 1.0f, gl + 3 * D, false); }
        else if constexpr (HAS(3) && q == 13) { MKCTX; const float* gl = C.gains + (size_t)l * 6 * D; if (l == 0) convert_weights(C, 1, lds3); thin_phase<FF / 256>(C, Y0, 0.5f, gl + 5 * D, l == 1); }
        else if constexpr (HAS(4) && q == 3) { MKCTX;
            pg8::Gemm g{C.XN, Wb + W_IN / 2, M, NINP, D, D, D}; pg8::StaticOrder S; S.init(M, NINP, C.G, C.bid);
            pg8::EpiIn E{C.P, PIN, C.out + O_KP + (size_t)l * MP * 512, C.out + O_VP + (size_t)l * MP * 512, C.out + O_KS + (size_t)l * MS * 512, C.out + O_VS + (size_t)l * MS * 512, MP, C.rs};
            pg8::gemm_phase<pg8::EpiIn, pg8::StaticOrder, true, true>(lds3, g, S, E, C.tid);
        } else if constexpr (HAS(5) && q == 4) { MKCTX;
            for (int u = C.bid; u < 512; u += C.G) { const int cc = u >> 2; gdn_pre_unit(C, l, 128 * (cc >> 5) + (cc & 31), u & 3, lds); } }
        else if constexpr ((HAS(6) || HAS(7)) && q == 5) { MKCTX;
            unsigned* qw = C.ctl + 64 * (1 + l); volatile unsigned* lq_ = (volatile unsigned*)(lds + LDS_Q);
            if (HAS(6) && C.bid < 64) {
                const unsigned long long tq0_ = PROBE_SEL ? __builtin_amdgcn_s_memrealtime() : 0ull;
                scan_unit(C, l, 0, C.bid >> 4, (C.bid >> 2) & 3, C.bid & 3, lds, &xbar);
                if (PROBE_SEL) tsel = __builtin_amdgcn_s_memrealtime() - tq0_; }
            int stage = (HAS(6) && C.bid < 64) ? 4 : 1;
            for (;;) {
                if (stage < 4) { const int nu = (stage == 3) ? 544 : 512;
                    for (int u = C.bid - 64; u < nu; u += C.G - 64) { const int cc = u >> 2;
                        if (u < 512) gdn_pre_unit(C, l, 128 * (cc >> 5) + 32 * stage + (cc & 31), u & 3, lds); else gdn_pre_unit(C, l, 512 + ((u - 512) >> 2), u & 3, lds); } }
                if (C.tid == 0) lq_[0] = atomicAdd(qw, 1u);
                lds_barrier();
                const int it = (int)lq_[0];
                lds_barrier();
                if (it < 1024 + 64 + 128) {
                    if (HAS(7) && it < 1024) attn_unit(C, l, 0, (it & 31) >> 3, it & 7, 31 - (it >> 5), lds);
                    else if (HAS(7) && it < 1088) { const int a = it - 1024; attn_unit(C, l, 1, a >> 3, a & 7, 0, lds); }
                    else if (HAS(6)) { const int s2 = it - 1088; scan_unit(C, l, 1, s2 >> 4, (s2 >> 2) & 3, s2 & 3, lds, nullptr); }
                } else if (stage >= 4) break;
                if (stage < 4) { xcd_barrier(xbar); ++stage; }
            }
        } else if constexpr (HAS(8) && q == 6) { MKCTX; gdn_norm_phase(C, l); }
        else if constexpr (HAS(9) && q == 7) { MKCTX;
#pragma unroll 1
            for (int br = 0; br < 2; ++br) { pg8::Gemm g{C.P + (br ? 3072 : 0), Wb + (br ? W_BGD : W_BSB) / 2, M, D, 512, PIN, 512}; pg8::StaticOrder S; S.init(M, D, C.G, C.bid); pg8::EpiPlain E{br ? Y1 : Y0, D};
              pg8::gemm_phase<pg8::EpiPlain, pg8::StaticOrder, true, true>(lds3, g, S, E, C.tid); }
        } else if constexpr (HAS(10) && q == 8) { MKCTX;
            pg8::Gemm g{C.XN, Wb + W_G / 2, M, NGATE, D, D, D}; pg8::StaticOrder S; S.init(M, NGATE, C.G, C.bid);
            pg8::EpiGate E{Y0, Y1, C.rs}; pg8::gemm_phase<pg8::EpiGate, pg8::StaticOrder, true, true>(lds3, g, S, E, C.tid);
        }
    return tsel;
}
template <int ph> __device__ __forceinline__ void run_phase_b(unsigned char* lds, int wv) {
    constexpr int l = (ph - 1) / 14, q = (ph - 1) % 14;
    if constexpr (HAS(2) && ph > 0 && (q == 1 || q == 12 || q == 9)) {
        const __attribute__((address_space(4))) Args* ap = (const __attribute__((address_space(4))) Args*)__builtin_amdgcn_kernarg_segment_ptr();
        int bid_ = blockIdx.x;
        asm volatile("" : "+s"(ap), "+s"(bid_));
        unsigned char* ws_ = ap->ws;
        const bf16* A = (q == 9) ? (const bf16*)(ws_ + WS_YT) : (const bf16*)(ws_ + WS_R1); constexpr int K = (q == 9) ? D : FF;
        const bf16* W = (const bf16*)(ws_ + WS_W) + (q == 1 ? W_DN1 : q == 12 ? W_DN2 : W_OUT) / 2;
        pg8::Gemm g{A + (size_t)MP * K, W, MS, D, 256, K, K}; pg8::SplitKOrder S{K / 256, (int)gridDim.x, bid_};
        pg8::EpiPart E{(float*)(ws_ + WS_OR)}; pg8::gemm_phase<pg8::EpiPart, pg8::SplitKOrder, true, true>((LAS unsigned char*)lds, g, S, E, wv * 64 + (int)__builtin_amdgcn_mbcnt_hi(~0u, __builtin_amdgcn_mbcnt_lo(~0u, 0u)));
    }
}
__global__ void __launch_bounds__(512, 2) fwd(Args args) {
    extern __shared__ __attribute__((aligned(16))) unsigned char lds[];
    const int lo = args.ph_lo, hi = args.ph_hi;
    const int wv = __builtin_amdgcn_readfirstlane(threadIdx.x >> 6);
    volatile LAS unsigned* xst = (volatile LAS unsigned*)((LAS unsigned char*)lds + LDS_Q + 16);
    if (threadIdx.x < 2) xst[threadIdx.x] = 0u;
    __syncthreads();
    (void)xcd_barrier_post((unsigned*)args.ws + 2048, xst);
#ifndef PROBE_MASK
#define PROBE_MASK 0u
#define PROBE_AMP 4
#endif
    unsigned long long tacc = 0ull;
#define RUN(P) if ((P) >= lo && (P) < hi) { XcdBarrier xbar; xbar.bar = (unsigned*)args.ws + 2048; xbar.x = xb_xcc_id(); xbar.st = xst; unsigned long long t0_ = 0ull; if ((PROBE_MASK >> (P)) & 1u) t0_ = __builtin_amdgcn_s_memrealtime(); \
        const unsigned long long ts_ = run_phase<P>(lds, xbar, wv); run_phase_b<P>(lds, wv); if (PROBE_SEL) tacc += ts_; if ((P) + 1 < hi) { if ((P) == 0 && lo < 0) cg::this_grid().sync(); else xcd_barrier(xbar); }     if ((PROBE_MASK >> (P)) & 1u) tacc += __builtin_amdgcn_s_memrealtime() - t0_; }
    RUN(0) RUN(1) RUN(2) RUN(3) RUN(4) RUN(5) RUN(6) RUN(7) RUN(8) RUN(9) RUN(10) RUN(11) RUN(12) RUN(13) RUN(14)
    RUN(15) RUN(16) RUN(17) RUN(18) RUN(19) RUN(20) RUN(21) RUN(22) RUN(23) RUN(24) RUN(25) RUN(26) RUN(27) RUN(28)
    if ((PROBE_MASK != 0u || PROBE_SEL) && blockIdx.x == 0 && threadIdx.x == 0) { const unsigned long long t1_ = __builtin_amdgcn_s_memrealtime(); while (__builtin_amdgcn_s_memrealtime() - t1_ < (unsigned long long)PROBE_AMP * tacc) __builtin_amdgcn_s_sleep(8); }
#undef RUN
}

#ifndef MK_SINGLE
#define MK_SINGLE 1
#endif
extern "C" void kernel_launch(void* const* d_in, const int* in_sizes, int n_in, void* d_out, int out_size, void* d_ws, size_t ws_size, hipStream_t stream) {
    static int grid = 0;
    if (grid == 0) {
        if (n_in != 19 || (size_t)out_size < O_END || ws_size < WS_END) { fprintf(stderr, "kernel_launch: unexpected shapes (n_in %d, out %d, ws %zu)\n", n_in, out_size, ws_size); grid = -1; return; }
        int dev = 0, cus = 0, per_cu = 0;
        hipGetDevice(&dev); hipDeviceGetAttribute(&cus, hipDeviceAttributeMultiprocessorCount, dev);
        if (hipFuncSetAttribute((const void*)fwd, hipFuncAttributeMaxDynamicSharedMemorySize, LDS_BYTES) != hipSuccess) { fprintf(stderr, "kernel_launch: hipFuncSetAttribute failed\n"); grid = -1; return; }
        hipOccupancyMaxActiveBlocksPerMultiprocessor(&per_cu, (const void*)fwd, 512, LDS_BYTES);
        if (per_cu < 1) { fprintf(stderr, "kernel_launch: occupancy query says %d\n", per_cu); per_cu = 1; }
        (void)hipGetLastError();
        grid = cus;
    }
    if (grid < 0) return;
    hipMemsetAsync((char*)d_ws + WS_CTL, 0, CTL_BYTES, stream);
    Args a{};
    for (int i = 0; i < 19; ++i) a.in[i] = (const float*)d_in[i];
    a.out = (float*)d_out; a.ws = (unsigned char*)d_ws;
#if MK_SINGLE
    a.ph_lo = 0; a.ph_hi = NPH;
    void* kargs[] = {&a};
    hipError_t e = hipLaunchCooperativeKernel((const void*)fwd, dim3(grid), dim3(512), kargs, LDS_BYTES, stream);
    if (e != hipSuccess) fprintf(stderr, "cooperative launch failed: %s (grid %d)\n", hipGetErrorString(e), grid);
#else
    for (int ph = 0; ph < NPH; ++ph) { a.ph_lo = ph; a.ph_hi = ph + 1; hipLaunchKernelGGL(fwd, dim3(grid), dim3(512), LDS_BYTES, stream, a); }
#endif
}
```
